# Optimizing an MI355X kernel written in HIP

```python
import jax, jax.numpy as jnp
from jax import lax
import numpy as np

D_MODEL = 1024
BATCH = 8
SEQ = 4096
DEPTH = 4

CTX_LEN = 256
GRID_W = 64
N_MIXERS = 3
EPS = 1e-6
D_FF = 4 * D_MODEL
N_MOD = 6

GLA_HEADS = 4
GLA_DK = D_MODEL // 2 // GLA_HEADS
GLA_DV = D_MODEL // GLA_HEADS
GLA_GATE_RANK = 16
GLA_GATE_TAU = 16.0
GLA_CHUNK = 64

RNN_WIDTH = D_MODEL
RNN_BLOCKS = 8
RNN_BLOCK_DIM = RNN_WIDTH // RNN_BLOCKS
CONV_WIDTH = 4
CONV_LEFT = 2
LRU_C = 8.0

HEAD_DIM = 128
Q_HEADS = D_MODEL // HEAD_DIM
KV_HEADS = 2
GROUP = Q_HEADS // KV_HEADS
Q_BLOCK = 128
ROPE_THETA = 10000.0

kernel_name = "hybrid_gla_rglru_gqa_dit_prefix"


def rmsnorm(x, g):
    xf = x.astype(jnp.float32)
    y = xf * lax.rsqrt(jnp.mean(xf * xf, axis=-1, keepdims=True) + EPS)
    return (y * g.astype(jnp.float32)).astype(x.dtype)


def adaln(x, g, shift, scale):
    return rmsnorm(x, g) * (1 + scale) + shift


def flip(a):
    return jnp.flip(a, axis=1)


def gla_chunk_scan(q, k, v, log_g, s0, with_output):
    B_, T, H, _ = q.shape
    n = T // GLA_CHUNK

    def chunks(a):
        return jnp.moveaxis(a.astype(jnp.float32).reshape(B_, n, GLA_CHUNK, H, a.shape[-1]), 1, 0)

    in_chunk_mask = jnp.tril(jnp.ones((GLA_CHUNK, GLA_CHUNK), dtype=bool))[None, :, :, None, None]

    def step(s, inp):
        qc, kc, vc, gc = inp
        b = jnp.cumsum(gc, axis=1)
        b_end = b[:, -1]
        s_new = s * jnp.exp(b_end)[..., None] + jnp.einsum(
            'bshk,bshv->bhkv', kc * jnp.exp(b_end[:, None] - b), vc)
        if not with_output:
            return s_new, None
        rel = jnp.where(in_chunk_mask, b[:, :, None] - b[:, None, :], -jnp.inf)
        scores = jnp.einsum('bthk,btshk,bshk->bhts', qc, jnp.exp(rel), kc)
        o = (jnp.einsum('bhts,bshv->bthv', scores, vc)
             + jnp.einsum('bthk,bhkv->bthv', qc * jnp.exp(b), s))
        return s_new, o

    s_fin, o = lax.scan(step, s0, (chunks(q), chunks(k), chunks(v), chunks(log_g)))
    if with_output:
        o = jnp.moveaxis(o, 0, 1).reshape(B_, T, H, -1).astype(v.dtype)
    return s_fin, o


def gla_mixer(h_c, h_l, w_in, w_up_f, b_f, w_up_b, b_b, norm_g, w_o, need_ctx):
    dq = GLA_HEADS * GLA_DK
    dv = GLA_HEADS * GLA_DV
    cuts = [dq, 2 * dq, 2 * dq + dv, 2 * dq + 2 * dv, 2 * dq + 2 * dv + GLA_GATE_RANK]

    def project(h):
        B_, T, _ = h.shape
        q, k, v, r, gf, gb = jnp.split(h @ w_in, cuts, axis=-1)
        heads = lambda a, d: a.reshape(B_, T, GLA_HEADS, d)
        log_f = jax.nn.log_sigmoid((gf @ w_up_f + b_f).astype(jnp.float32)) / GLA_GATE_TAU
        log_b = jax.nn.log_sigmoid((gb @ w_up_b + b_b).astype(jnp.float32)) / GLA_GATE_TAU
        return (heads(q, GLA_DK) * GLA_DK ** -0.5, heads(k, GLA_DK), heads(v, GLA_DV), r,
                heads(log_f, GLA_DK), heads(log_b, GLA_DK))

    def readout(o, r):
        B_, T = o.shape[:2]
        o = rmsnorm(o, norm_g).reshape(B_, T, GLA_HEADS * GLA_DV)
        return (o * jax.nn.silu(r)) @ w_o

    qc, kc, vc, rc, gfc, gbc = project(h_c)
    ql, kl, vl, rl, gfl, gbl = project(h_l)
    s0 = jnp.zeros((h_l.shape[0], GLA_HEADS, GLA_DK, GLA_DV), jnp.float32)
    s_cf, o_cf = gla_chunk_scan(qc, kc, vc, gfc, s0, need_ctx)
    s_cb, o_cb = gla_chunk_scan(flip(qc), flip(kc), flip(vc), flip(gbc), s0, need_ctx)
    _, o_lf = gla_chunk_scan(ql, kl, vl, gfl, s_cf, True)
    _, o_lb = gla_chunk_scan(flip(ql), flip(kl), flip(vl), flip(gbl), s_cb, True)
    out_l = readout(o_lf + flip(o_lb), rl)
    out_c = readout(o_cf + flip(o_cb), rc) if need_ctx else None
    return out_c, out_l


def depthwise_conv(x, w, b):
    T = x.shape[1]
    xp = jnp.pad(x, ((0, 0), (CONV_LEFT, CONV_WIDTH - 1 - CONV_LEFT), (0, 0)))
    y = b
    for j in range(CONV_WIDTH):
        y = y + xp[:, j:j + T] * w[j]
    return y


def block_diag_linear(x, w, b):
    B_, T, _ = x.shape
    y = jnp.einsum('btnd,nde->btne', x.reshape(B_, T, RNN_BLOCKS, RNN_BLOCK_DIM), w)
    return y.reshape(B_, T, RNN_WIDTH) + b


def _linear_combine(e1, e2):
    a1, b1 = e1
    a2, b2 = e2
    return a1 * a2, a2 * b1 + b2


def rg_lru(x, w_a, b_a, w_x, b_x, lam, h0):
    xf = x.astype(jnp.float32)
    r = jax.nn.sigmoid(block_diag_linear(xf, w_a, b_a))
    i = jax.nn.sigmoid(block_diag_linear(xf, w_x, b_x))
    log_a = -LRU_C * r * jax.nn.softplus(-lam.astype(jnp.float32))
    a = jnp.exp(log_a)
    u = jnp.sqrt(-jnp.expm1(2.0 * log_a)) * (i * xf)
    a_cum, h = lax.associative_scan(_linear_combine, (a, u), axis=1)
    h = h + a_cum * h0[:, None, :]
    return h, h[:, -1]


def lru_mixer(h_c, h_l, w_in, conv_w, conv_b, wa_f, ba_f, wx_f, bx_f, lam_f,
              wa_b, ba_b, wx_b, bx_b, lam_b, w_o, need_ctx):
    def branches(h):
        gate, xb = jnp.split(h @ w_in, 2, axis=-1)
        return gate, depthwise_conv(xb, conv_w, conv_b)

    def readout(hs, gate):
        return (hs * jax.nn.gelu(gate.astype(jnp.float32))).astype(gate.dtype) @ w_o

    gc, xc = branches(h_c)
    gl, xl = branches(h_l)
    h0 = jnp.zeros((h_l.shape[0], RNN_WIDTH), jnp.float32)
    hcf, scf = rg_lru(xc, wa_f, ba_f, wx_f, bx_f, lam_f, h0)
    hcb, scb = rg_lru(flip(xc), wa_b, ba_b, wx_b, bx_b, lam_b, h0)
    hlf, _ = rg_lru(xl, wa_f, ba_f, wx_f, bx_f, lam_f, scf)
    hlb, _ = rg_lru(flip(xl), wa_b, ba_b, wx_b, bx_b, lam_b, scb)
    out_l = readout(hlf + flip(hlb), gl)
    out_c = readout(hcf + flip(hcb), gc) if need_ctx else None
    return out_c, out_l


def rope_2d_tables(T):
    n_rows = T // GRID_W
    row = jnp.repeat(jnp.arange(n_rows), GRID_W)
    col = jnp.tile(jnp.arange(GRID_W), n_rows)
    n_pairs_axis = HEAD_DIM // 4
    inv_freq = ROPE_THETA ** (-jnp.arange(n_pairs_axis, dtype=jnp.float32) / n_pairs_axis)
    ang = jnp.concatenate([row[:, None] * inv_freq, col[:, None] * inv_freq], axis=-1)
    return jnp.cos(ang)[None, :, None, :], jnp.sin(ang)[None, :, None, :]


def apply_rope(x, cos, sin):
    xf = x.astype(jnp.float32)
    x1, x2 = jnp.split(xf, 2, axis=-1)
    return jnp.concatenate([x1 * cos - x2 * sin, x1 * sin + x2 * cos], axis=-1).astype(x.dtype)


def gqa_attend(q, k, v):
    s = jnp.einsum('bqhgd,bkhd->bhgqk', q, k).astype(jnp.float32) * HEAD_DIM ** -0.5
    p = jax.nn.softmax(s, axis=-1).astype(v.dtype)
    return jnp.einsum('bhgqk,bkhd->bqhgd', p, v)


def attn_mixer(h_c, h_l, w_in, q_g, k_g, w_o, need_ctx):
    def project(h):
        B_, T, _ = h.shape
        q, k, v = jnp.split(h @ w_in, [Q_HEADS * HEAD_DIM, (Q_HEADS + KV_HEADS) * HEAD_DIM], axis=-1)
        q = rmsnorm(q.reshape(B_, T, Q_HEADS, HEAD_DIM), q_g)
        k = rmsnorm(k.reshape(B_, T, KV_HEADS, HEAD_DIM), k_g)
        return q, k, v.reshape(B_, T, KV_HEADS, HEAD_DIM)

    qc, kc, vc = project(h_c)
    ql, kl, vl = project(h_l)
    B_, T = h_l.shape[:2]
    cos, sin = rope_2d_tables(T)
    ql = apply_rope(ql, cos, sin)
    kl = apply_rope(kl, cos, sin)
    k_all = jnp.concatenate([kc, kl], axis=1)
    v_all = jnp.concatenate([vc, vl], axis=1)
    qb = jnp.swapaxes(ql.reshape(B_, T // Q_BLOCK, Q_BLOCK, KV_HEADS, GROUP, HEAD_DIM), 0, 1)
    ob = lax.map(lambda qq: gqa_attend(qq, k_all, v_all), qb)
    out_l = jnp.swapaxes(ob, 0, 1).reshape(B_, T, Q_HEADS * HEAD_DIM) @ w_o
    out_c = None
    if need_ctx:
        Tc = h_c.shape[1]
        oc = gqa_attend(qc.reshape(B_, Tc, KV_HEADS, GROUP, HEAD_DIM), kc, vc)
        out_c = oc.reshape(B_, Tc, Q_HEADS * HEAD_DIM) @ w_o
    return out_c, out_l


def sq_relu_mlp(h, w1, w2):
    return jnp.square(jax.nn.relu(h @ w1)) @ w2


def setup_inputs(seed: int = 0) -> dict:
    key = jax.random.key(seed)
    ks = iter(jax.random.split(key, 64))

    def nrm(shape, scale):
        return jax.random.normal(next(ks), shape, jnp.float32) * scale

    def gain(shape):
        return 1.0 + nrm(shape, 0.02)

    def lru_lambda(n):
        a0 = jax.random.uniform(next(ks), (n, RNN_WIDTH), jnp.float32, minval=0.9, maxval=0.999)
        s = a0 ** (1.0 / LRU_C)
        return jnp.log(s) - jnp.log1p(-s)

    n_a, n_b, n_c = (len(range(kind, DEPTH, N_MIXERS)) for kind in range(N_MIXERS))
    D = D_MODEL
    gla_in = 2 * GLA_HEADS * GLA_DK + 2 * GLA_HEADS * GLA_DV + 2 * GLA_GATE_RANK
    gla_kw = GLA_HEADS * GLA_DK
    bd = RNN_BLOCK_DIM ** -0.5
    return {
        "x": nrm((BATCH, SEQ, D), 1.0),
        "c": nrm((BATCH, D), 1.0),
        "ctx": nrm((BATCH, CTX_LEN, D), 1.0),
        "c_ctx": nrm((D,), 1.0),
        "norm_mix_g": gain((DEPTH, D)),
        "norm_mlp_g": gain((DEPTH, D)),
        "w_mod": nrm((DEPTH, D, N_MOD * D), 0.5 * D ** -0.5),
        "b_mod": nrm((DEPTH, N_MOD * D), 0.02),
        "w_mlp1": nrm((DEPTH, D, D_FF), D ** -0.5),
        "w_mlp2": nrm((DEPTH, D_FF, D), D_FF ** -0.5),
        "gla_w_in": nrm((n_a, D, gla_in), D ** -0.5),
        "gla_w_up_f": nrm((n_a, GLA_GATE_RANK, gla_kw), GLA_GATE_RANK ** -0.5),
        "gla_b_f": nrm((n_a, gla_kw), 0.1),
        "gla_w_up_b": nrm((n_a, GLA_GATE_RANK, gla_kw), GLA_GATE_RANK ** -0.5),
        "gla_b_b": nrm((n_a, gla_kw), 0.1),
        "gla_norm_g": gain((n_a, GLA_DV)),
        "gla_w_o": nrm((n_a, GLA_HEADS * GLA_DV, D), (GLA_HEADS * GLA_DV) ** -0.5),
        "lru_w_in": nrm((n_b, D, 2 * RNN_WIDTH), D ** -0.5),
        "lru_conv_w": nrm((n_b, CONV_WIDTH, RNN_WIDTH), 0.5),
        "lru_conv_b": nrm((n_b, RNN_WIDTH), 0.02),
        "lru_wa_f": nrm((n_b, RNN_BLOCKS, RNN_BLOCK_DIM, RNN_BLOCK_DIM), bd),
        "lru_ba_f": nrm((n_b, RNN_WIDTH), 0.1),
        "lru_wx_f": nrm((n_b, RNN_BLOCKS, RNN_BLOCK_DIM, RNN_BLOCK_DIM), bd),
        "lru_bx_f": nrm((n_b, RNN_WIDTH), 0.1),
        "lru_lam_f": lru_lambda(n_b),
        "lru_wa_b": nrm((n_b, RNN_BLOCKS, RNN_BLOCK_DIM, RNN_BLOCK_DIM), bd),
        "lru_ba_b": nrm((n_b, RNN_WIDTH), 0.1),
        "lru_wx_b": nrm((n_b, RNN_BLOCKS, RNN_BLOCK_DIM, RNN_BLOCK_DIM), bd),
        "lru_bx_b": nrm((n_b, RNN_WIDTH), 0.1),
        "lru_lam_b": lru_lambda(n_b),
        "lru_w_o": nrm((n_b, RNN_WIDTH, D), RNN_WIDTH ** -0.5),
        "attn_w_in": nrm((n_c, D, (Q_HEADS + 2 * KV_HEADS) * HEAD_DIM), D ** -0.5),
        "attn_q_g": gain((n_c, HEAD_DIM)),
        "attn_k_g": gain((n_c, HEAD_DIM)),
        "attn_w_o": nrm((n_c, Q_HEADS * HEAD_DIM, D), (Q_HEADS * HEAD_DIM) ** -0.5),
        "final_g": gain((D,)),
    }


def reference(x, c, ctx, c_ctx, norm_mix_g, norm_mlp_g, w_mod, b_mod, w_mlp1, w_mlp2,
              gla_w_in, gla_w_up_f, gla_b_f, gla_w_up_b, gla_b_b, gla_norm_g, gla_w_o,
              lru_w_in, lru_conv_w, lru_conv_b, lru_wa_f, lru_ba_f, lru_wx_f, lru_bx_f, lru_lam_f,
              lru_wa_b, lru_ba_b, lru_wx_b, lru_bx_b, lru_lam_b, lru_w_o,
              attn_w_in, attn_q_g, attn_k_g, attn_w_o, final_g):
    silu_c = jax.nn.silu(c)
    silu_cc = jax.nn.silu(c_ctx)
    for i in range(DEPTH):
        need_ctx = i < DEPTH - 1
        m_l = (silu_c @ w_mod[i] + b_mod[i])[:, None, :]
        m_c = (silu_cc @ w_mod[i] + b_mod[i])[None, None, :]
        sh1, sc1, g1, sh2, sc2, g2 = jnp.split(m_l, N_MOD, axis=-1)
        csh1, csc1, cg1, csh2, csc2, cg2 = jnp.split(m_c, N_MOD, axis=-1)
        h_l = adaln(x, norm_mix_g[i], sh1, sc1)
        h_c = adaln(ctx, norm_mix_g[i], csh1, csc1)
        kind = i % N_MIXERS
        j = i // N_MIXERS
        if kind == 0:
            o_c, o_l = gla_mixer(h_c, h_l, gla_w_in[j], gla_w_up_f[j], gla_b_f[j], gla_w_up_b[j],
                                 gla_b_b[j], gla_norm_g[j], gla_w_o[j], need_ctx)
        elif kind == 1:
            o_c, o_l = lru_mixer(h_c, h_l, lru_w_in[j], lru_conv_w[j], lru_conv_b[j],
                                 lru_wa_f[j], lru_ba_f[j], lru_wx_f[j], lru_bx_f[j], lru_lam_f[j],
                                 lru_wa_b[j], lru_ba_b[j], lru_wx_b[j], lru_bx_b[j], lru_lam_b[j],
                                 lru_w_o[j], need_ctx)
        else:
            o_c, o_l = attn_mixer(h_c, h_l, attn_w_in[j], attn_q_g[j], attn_k_g[j], attn_w_o[j], need_ctx)
        x = x + g1 * o_l
        x = x + g2 * sq_relu_mlp(adaln(x, norm_mlp_g[i], sh2, sc2), w_mlp1[i], w_mlp2[i])
        if need_ctx:
            ctx = ctx + cg1 * o_c
            ctx = ctx + cg2 * sq_relu_mlp(adaln(ctx, norm_mlp_g[i], csh2, csc2), w_mlp1[i], w_mlp2[i])
    return rmsnorm(x, final_g)
```

```cpp
#include <hip/hip_runtime.h>
#include <hip/hip_cooperative_groups.h>
#include <cstdio>
#include <cstdint>
namespace cg = cooperative_groups;

typedef unsigned short u16;
typedef __attribute__((ext_vector_type(8))) short bf16x8;
typedef __attribute__((ext_vector_type(4))) short s16x4;
typedef __attribute__((ext_vector_type(4))) float f32x4;
typedef __attribute__((ext_vector_type(16))) float f32x16;
typedef __attribute__((ext_vector_type(4))) unsigned u32x4;
typedef __attribute__((ext_vector_type(2))) unsigned u32x2;

constexpr int NTHR = 512;
constexpr int DM = 1024, NBATCH = 8, SEQL = 4096, CTXL = 256;
constexpr int ML = NBATCH * SEQL;
constexpr int MC = NBATCH * CTXL;
constexpr int MT = ML + MC;
constexpr float EPSN = 1e-6f;
constexpr int LDP = 3104;
constexpr int NKEY = CTXL + SEQL;

constexpr size_t OFF_XS   = 0;
constexpr size_t OFF_WMIX = OFF_XS + (size_t)MT * 1024 * 4;
constexpr size_t OFF_WMLP = OFF_WMIX + 9437184;
constexpr size_t OFF_MOD  = OFF_WMLP + 16777216;
constexpr size_t OFF_BAR  = OFF_MOD + 884736;
constexpr size_t OFF_S    = OFF_BAR + 16384;
constexpr size_t OUT_GAM  = 0;
constexpr size_t OUT_BIAS = OUT_GAM + 4 * 2 * 9 * 1024 * 4;
constexpr size_t OUT_SSQ  = OUT_BIAS + 4 * 2 * 9 * 4096 * 4;
constexpr size_t OUT_H    = OUT_SSQ + (size_t)MT * 16 * 4;
constexpr size_t OUT_END  = OUT_H + (size_t)MT * 1024 * 2;
constexpr size_t OUT_GKB  = OUT_END;
constexpr size_t OUT_EBE  = OUT_GKB + (size_t)MT * 512 * 2;
constexpr size_t OUT_END2 = OUT_EBE + (size_t)2 * 544 * 512 * 4;
constexpr size_t WS_NEED  = OFF_S + (size_t)300000000 + (size_t)MT * 512 * 2;
constexpr size_t OFF_GLA_OB = OFF_S + (size_t)MT * LDP * 2;
constexpr int SMEM_BYTES = 147456;

struct Params {
  const float* in[36];
  float* out;
  char* ws;
};

__device__ __forceinline__ unsigned cvtpk(float lo, float hi) {
  unsigned r; asm("v_cvt_pk_bf16_f32 %0, %1, %2" : "=v"(r) : "v"(lo), "v"(hi)); return r;
}
__device__ __forceinline__ u16 f2bf(float x) { return (u16)(cvtpk(x, 0.f) & 0xffffu); }
__device__ __forceinline__ float bf2f(u16 x) { return __uint_as_float(((unsigned)x) << 16); }
__device__ __forceinline__ float bflo(unsigned w) { return __uint_as_float(w << 16); }
__device__ __forceinline__ float bfhi(unsigned w) { return __uint_as_float(w & 0xffff0000u); }
__device__ __forceinline__ float wave_sum_l(float v, int lane) {
#pragma unroll
  for (int o = 32; o > 0; o >>= 1) v += __int_as_float(__builtin_amdgcn_ds_bpermute((lane ^ o) << 2, __float_as_int(v)));
  return v;
}
#define wave_sum(v) wave_sum_l((v), lane)
__device__ __forceinline__ float fexp(float x) { return __builtin_amdgcn_exp2f(x * 1.4426950408889634f); }
__device__ __forceinline__ float flog(float x) { return __builtin_amdgcn_logf(x) * 0.6931471805599453f; }
__device__ __forceinline__ float sigmoidf_(float x) { return __builtin_amdgcn_rcpf(1.f + fexp(-x)); }
__device__ __forceinline__ int swz128(int row, int chunk) { return row * 128 + ((chunk ^ ((row >> 1) & 7)) << 4); }
__device__ __forceinline__ int swz256(int row, int chunk) { return row * 256 + ((chunk ^ (row & 15)) << 4); }
__device__ __forceinline__ int crow(int r, int hi) { return (r & 3) + 8 * (r >> 2) + 4 * hi; }

__device__ __forceinline__ const float* resid_row(const Params& p, bool first, int row) {
  if (!first) return (const float*)(p.ws + OFF_XS) + (size_t)row * 1024;
  return row < ML ? p.in[0] + (size_t)row * 1024 : p.in[2] + (size_t)(row - ML) * 1024;
}

__device__ __forceinline__ void cvt_matrix(const float* __restrict__ src, int ldsrc, int K, int Nsrc, int Npad,
                                           u16* __restrict__ dst, int& ctr, float* tl, int tid, int bid, int G) {
  const int nn = Npad / 64, T = (K / 64) * nn;
  int first = ((bid - ctr) % G + G) % G;
  if (bid < 0) first = T;
  for (int t = first; t < T; t += G) {
    const int k0 = (t / nn) * 64, n0 = (t % nn) * 64;
    {
      const int r = tid >> 4, c4 = (tid & 15) * 4;
#pragma unroll
      for (int i = 0; i < 2; ++i) {
        const int rr = r + 32 * i;
        float4 v = make_float4(0.f, 0.f, 0.f, 0.f);
        if (n0 + c4 < Nsrc) v = *(const float4*)(src + (size_t)(k0 + rr) * ldsrc + n0 + c4);
        float* d = tl + rr * 65 + c4;
        d[0] = v.x; d[1] = v.y; d[2] = v.z; d[3] = v.w;
      }
    }
    __syncthreads();
    {
      const int n = tid >> 3, k8 = (tid & 7) * 8;
      float f[8];
#pragma unroll
      for (int i = 0; i < 8; ++i) f[i] = tl[(k8 + i) * 65 + n];
      u32x4 w = {cvtpk(f[0], f[1]), cvtpk(f[2], f[3]), cvtpk(f[4], f[5]), cvtpk(f[6], f[7])};
      *(u32x4*)(dst + (size_t)(n0 + n) * K + k0 + k8) = w;
    }
    __syncthreads();
  }
  ctr += T;
}

__device__ __forceinline__ void cvt_layer(const Params& p, int l, char* smem, int tid, int bid, int G, bool do_mix, bool do_mlp) {
  int ctr = 0; float* tl = (float*)smem;
  const int kind = l % 3, j = l / 3;
  u16* wm = (u16*)(p.ws + OFF_WMIX);
  u16* wp = (u16*)(p.ws + OFF_WMLP);
  if (do_mix) {
  if (kind == 0) {
    cvt_matrix(p.in[10] + (size_t)j * 1024 * 3104, 3104, 1024, 3104, 3328, wm, ctr, tl, tid, bid, G);
    cvt_matrix(p.in[16] + (size_t)j * 1024 * 1024, 1024, 1024, 1024, 1024, wm + 3328 * 1024, ctr, tl, tid, bid, G);
  } else if (kind == 1) {
    cvt_matrix(p.in[17] + (size_t)j * 1024 * 2048, 2048, 1024, 2048, 2048, wm, ctr, tl, tid, bid, G);
    cvt_matrix(p.in[30] + (size_t)j * 1024 * 1024, 1024, 1024, 1024, 1024, wm + 2048 * 1024, ctr, tl, tid, bid, G);
    u16* wb = wm + 3072 * 1024;
    for (int n = 0; n < 8; ++n) {
      cvt_matrix(p.in[20] + (size_t)(j * 8 + n) * 16384, 128, 128, 128, 128, wb + (0 * 8 + n) * 16384, ctr, tl, tid, bid, G);
      cvt_matrix(p.in[22] + (size_t)(j * 8 + n) * 16384, 128, 128, 128, 128, wb + (1 * 8 + n) * 16384, ctr, tl, tid, bid, G);
      cvt_matrix(p.in[25] + (size_t)(j * 8 + n) * 16384, 128, 128, 128, 128, wb + (2 * 8 + n) * 16384, ctr, tl, tid, bid, G);
      cvt_matrix(p.in[27] + (size_t)(j * 8 + n) * 16384, 128, 128, 128, 128, wb + (3 * 8 + n) * 16384, ctr, tl, tid, bid, G);
    }
  } else {
    cvt_matrix(p.in[31] + (size_t)j * 1024 * 1536, 1536, 1024, 1536, 1536, wm, ctr, tl, tid, bid, G);
    cvt_matrix(p.in[34] + (size_t)j * 1024 * 1024, 1024, 1024, 1024, 1024, wm + 1536 * 1024, ctr, tl, tid, bid, G);
  }
  }
  if (do_mlp) {
  cvt_matrix(p.in[8] + (size_t)l * 1024 * 4096, 4096, 1024, 4096, 4096, wp, ctr, tl, tid, bid, G);
  cvt_matrix(p.in[9] + (size_t)l * 4096 * 1024, 1024, 4096, 1024, 1024, wp + 4096 * 1024, ctr, tl, tid, bid, G);
  }
}

__device__ __forceinline__ void mod_phase(const Params& p, char* smem, int tid, int bid) {
  if (bid >= 192) return;
  float* sL = (float*)smem;
  float* red = sL + 9 * 1024;
  float* mod = (float*)(p.ws + OFF_MOD);
  for (int i = tid; i < 9 * 1024; i += NTHR) {
    float v = i < 8192 ? p.in[1][i] : p.in[3][i - 8192];
    sL[i] = v / (1.f + __expf(-v));
  }
  __syncthreads();
  for (int job = bid; job < 192; job += gridDim.x) {
    const int l = job / 48, cch = job % 48, cl = tid & 127, kg = tid >> 7;
    const float* W = p.in[6] + (size_t)l * 1024 * 6144 + cch * 128 + cl;
    float acc[9];
#pragma unroll
    for (int r = 0; r < 9; ++r) acc[r] = 0.f;
#pragma unroll 4
    for (int k = kg * 256; k < kg * 256 + 256; ++k) {
      const float w = W[(size_t)k * 6144];
#pragma unroll
      for (int r = 0; r < 9; ++r) acc[r] = fmaf(sL[r * 1024 + k], w, acc[r]);
    }
#pragma unroll
    for (int r = 0; r < 9; ++r) red[(kg * 9 + r) * 128 + cl] = acc[r];
    __syncthreads();
    for (int o = tid; o < 9 * 128; o += NTHR) {
      const int r = o >> 7, cc = o & 127;
      float s = red[(0 * 9 + r) * 128 + cc] + red[(1 * 9 + r) * 128 + cc] + red[(2 * 9 + r) * 128 + cc] + red[(3 * 9 + r) * 128 + cc];
      const float mv = s + p.in[7][(size_t)l * 6144 + cch * 128 + cc];
      mod[(size_t)(l * 9 + r) * 6144 + cch * 128 + cc] = mv;
      if ((cch >= 8 && cch < 16) || (cch >= 32 && cch < 40)) {
        const int which = cch >= 32 ? 1 : 0, c = (cch - (which ? 32 : 8)) * 128 + cc;
        const float g = (which ? p.in[5] : p.in[4])[(size_t)l * 1024 + c];
        ((float*)((char*)p.out + OUT_GAM))[(size_t)((l * 2 + which) * 9 + r) * 1024 + c] = g * (1.f + mv);
      }
    }
    __syncthreads();
  }
}


__device__ __forceinline__ void bias_phase(const Params& p, char* smem, int tid, int bid) {
  float* sL = (float*)smem;
  float* red = sL + 9 * 1024;
  const float* mod = (const float*)(p.ws + OFF_MOD);
  float* bias = (float*)((char*)p.out + OUT_BIAS);
  for (int job = bid; job < 206; job += gridDim.x) {
    int l, which, chunk, ncols, ld; const float* W;
    int q = job;
    if (q < 25) { l = 0; which = 0; chunk = q; } else if ((q -= 25) < 32) { l = 0; which = 1; chunk = q; }
    else if ((q -= 32) < 16) { l = 1; which = 0; chunk = q; } else if ((q -= 16) < 32) { l = 1; which = 1; chunk = q; }
    else if ((q -= 32) < 12) { l = 2; which = 0; chunk = q; } else if ((q -= 12) < 32) { l = 2; which = 1; chunk = q; }
    else if ((q -= 32) < 25) { l = 3; which = 0; chunk = q; } else { q -= 25; l = 3; which = 1; chunk = q; }
    if (which == 1) { ncols = 4096; ld = 4096; W = p.in[8] + (size_t)l * 1024 * 4096; }
    else if (l == 1) { ncols = 2048; ld = 2048; W = p.in[17]; }
    else if (l == 2) { ncols = 1536; ld = 1536; W = p.in[31]; }
    else { ncols = 3104; ld = 3104; W = p.in[10] + (size_t)(l / 3) * 1024 * 3104; }
    __syncthreads();
    for (int i = tid; i < 9 * 1024; i += NTHR) { const int r = i >> 10, k = i & 1023; sL[i] = mod[(size_t)(l * 9 + r) * 6144 + which * 3072 + k]; }
    __syncthreads();
    const int cl = tid & 127, kg = tid >> 7, col = chunk * 128 + cl;
    const bool valid = col < ncols;
    const float* Wc = W + (valid ? col : 0);
    float acc[9];
#pragma unroll
    for (int r = 0; r < 9; ++r) acc[r] = 0.f;
#pragma unroll 8
    for (int k = kg * 256; k < kg * 256 + 256; ++k) {
      const float w = Wc[(size_t)k * ld];
#pragma unroll
      for (int r = 0; r < 9; ++r) acc[r] = fmaf(sL[r * 1024 + k], w, acc[r]);
    }
#pragma unroll
    for (int r = 0; r < 9; ++r) red[(kg * 9 + r) * 128 + cl] = acc[r];
    __syncthreads();
    for (int o = tid; o < 9 * 128; o += NTHR) {
      const int r = o >> 7, cc = o & 127;
      const float sum = red[(0 * 9 + r) * 128 + cc] + red[(1 * 9 + r) * 128 + cc] + red[(2 * 9 + r) * 128 + cc] + red[(3 * 9 + r) * 128 + cc];
      if (chunk * 128 + cc < ncols) bias[(size_t)((l * 2 + which) * 9 + r) * 4096 + chunk * 128 + cc] = sum;
    }
  }
  __syncthreads();
}

__device__ __forceinline__ void norm_phase(const Params& p, int layer, int which, int Mrows, int tid, int bid) {
  const int lane = tid & 63, wid = tid >> 6;
  const float* mod = (const float*)(p.ws + OFF_MOD);
  const float* gsrc = (which == 0 ? p.in[4] : p.in[5]) + (size_t)layer * 1024;
  u16* H = (u16*)((char*)p.out + OUT_H);
  const bool first = (layer == 0 && which == 0);
  const int rstride = gridDim.x * 8;
  for (int row0 = bid * 8 + wid; row0 < Mrows; row0 += 2 * rstride) {
    float4 v[2][4];
#pragma unroll
    for (int q = 0; q < 2; ++q) {
      const int row = row0 + q * rstride;
      if (row < Mrows) {
        const float* xr = resid_row(p, first, row);
#pragma unroll
        for (int i = 0; i < 4; ++i) v[q][i] = ((const float4*)xr)[lane + 64 * i];
      }
    }
#pragma unroll
    for (int q = 0; q < 2; ++q) {
      const int row = row0 + q * rstride;
      if (row < Mrows) {
        float ss = 0.f;
#pragma unroll
        for (int i = 0; i < 4; ++i) ss += v[q][i].x * v[q][i].x + v[q][i].y * v[q][i].y + v[q][i].z * v[q][i].z + v[q][i].w * v[q][i].w;
        ss = wave_sum(ss);
        const float rstd = rsqrtf(ss * (1.f / 1024.f) + EPSN);
        const int midx = row < ML ? (row >> 12) : 8;
        const float* md = mod + (size_t)(layer * 9 + midx) * 6144 + which * 3072;
        float4 gv4[4], shv[4], scv[4];
#pragma unroll
        for (int i = 0; i < 4; ++i) { const int c = (lane + 64 * i) * 4; gv4[i] = *(const float4*)(gsrc + c); shv[i] = *(const float4*)(md + c); scv[i] = *(const float4*)(md + 1024 + c); }
#pragma unroll
        for (int i = 0; i < 4; ++i) {
          const int c = (lane + 64 * i) * 4;
          const float4 g = gv4[i], sh = shv[i], sc = scv[i];
          const float y0 = v[q][i].x * rstd * g.x * (1.f + sc.x) + sh.x, y1 = v[q][i].y * rstd * g.y * (1.f + sc.y) + sh.y;
          const float y2 = v[q][i].z * rstd * g.z * (1.f + sc.z) + sh.z, y3 = v[q][i].w * rstd * g.w * (1.f + sc.w) + sh.w;
          u32x2 w = {cvtpk(y0, y1), cvtpk(y2, y3)};
          *(u32x2*)(H + (size_t)row * 1024 + c) = w;
        }
      }
    }
  }
}

__device__ __forceinline__ void final_norm_phase(const Params& p, int tid, int bid) {
  const int lane = tid & 63, wid = tid >> 6;
  const u16* xs = (const u16*)(p.ws + OFF_XS);
  for (int rp = bid * 8 + wid; rp < ML / 2; rp += gridDim.x * 8) {
    u32x4 w[2][2];
#pragma unroll
    for (int q = 0; q < 2; ++q) { const u16* xr = xs + (size_t)(rp * 2 + q) * 1024; w[q][0] = *(const u32x4*)(xr + lane * 8); w[q][1] = *(const u32x4*)(xr + 512 + lane * 8); }
#pragma unroll
    for (int q = 0; q < 2; ++q) {
      const int row = rp * 2 + q;
      float v[16]; float ss = 0.f;
#pragma unroll
      for (int i = 0; i < 2; ++i)
#pragma unroll
        for (int k = 0; k < 4; ++k) { v[i * 8 + k * 2] = bflo(w[q][i][k]); v[i * 8 + k * 2 + 1] = bfhi(w[q][i][k]); }
#pragma unroll
      for (int i = 0; i < 16; ++i) ss += v[i] * v[i];
      ss = wave_sum(ss);
      const float rstd = rsqrtf(ss * (1.f / 1024.f) + EPSN);
#pragma unroll
      for (int i = 0; i < 2; ++i) {
        const int c = i * 512 + lane * 8;
        const float4 g0 = *(const float4*)(p.in[35] + c), g1 = *(const float4*)(p.in[35] + c + 4);
        *(float4*)(p.out + (size_t)row * 1024 + c) = make_float4(v[i * 8 + 0] * rstd * g0.x, v[i * 8 + 1] * rstd * g0.y, v[i * 8 + 2] * rstd * g0.z, v[i * 8 + 3] * rstd * g0.w);
        *(float4*)(p.out + (size_t)row * 1024 + c + 4) = make_float4(v[i * 8 + 4] * rstd * g1.x, v[i * 8 + 5] * rstd * g1.y, v[i * 8 + 6] * rstd * g1.z, v[i * 8 + 7] * rstd * g1.w);
      }
    }
  }
}

template <class Epi>
__device__ __forceinline__ void gemm_phase(const u16* __restrict__ A, int lda, const u16* __restrict__ Bt, int K, int Mrows, int N,
                                           const Epi& epi, char* smem, int tid, int bid) {
  const int lane = tid & 63, wid = tid >> 6, wm = wid >> 1, wn = wid & 1;
  const int fr = lane & 15, fq = lane >> 4;
  const int srow = tid >> 3, sch = tid & 7;
  const int nM = Mrows / 256, nN = N / 128, T = nM * nN, T8 = (T + 7) / 8;
  const int nk = K / 64;
  const int G = gridDim.x;
  for (int it = bid; it < T8 * 8; it += G) {
    const int v = (it & 7) * T8 + (it >> 3);
    if (v >= T) continue;
    const int m0 = (v / nN) * 256, n0 = (v % nN) * 128;
    f32x4 acc[4][4];
#pragma unroll
    for (int i = 0; i < 4; ++i)
#pragma unroll
      for (int j = 0; j < 4; ++j) acc[i][j] = f32x4{0.f, 0.f, 0.f, 0.f};
    const u16* Ag = A + (size_t)(m0 + srow) * lda + sch * 8;
    const u16* Bg = Bt + (size_t)(n0 + srow) * K + sch * 8;
    bf16x8 ra[4], rb[2];
#pragma unroll
    for (int i = 0; i < 4; ++i) ra[i] = *(const bf16x8*)(Ag + (size_t)i * 64 * lda);
#pragma unroll
    for (int i = 0; i < 2; ++i) rb[i] = *(const bf16x8*)(Bg + (size_t)i * 64 * K);
    const int woff = swz128(srow, sch);
    __syncthreads();
#pragma unroll
    for (int i = 0; i < 4; ++i) *(bf16x8*)(smem + woff + i * 8192) = ra[i];
#pragma unroll
    for (int i = 0; i < 2; ++i) *(bf16x8*)(smem + 65536 + woff + i * 8192) = rb[i];
    __syncthreads();
    for (int kt = 0; kt < nk; ++kt) {
      const int s = kt & 1;
      if (kt + 1 < nk) {
#pragma unroll
        for (int i = 0; i < 4; ++i) ra[i] = *(const bf16x8*)(Ag + (size_t)i * 64 * lda + (kt + 1) * 64);
#pragma unroll
        for (int i = 0; i < 2; ++i) rb[i] = *(const bf16x8*)(Bg + (size_t)i * 64 * K + (kt + 1) * 64);
      }
      const char* sA = smem + s * 32768;
      const char* sB = smem + 65536 + s * 16384;
#pragma unroll
      for (int kk = 0; kk < 2; ++kk) {
        const int ch = kk * 4 + fq;
        bf16x8 af[4], bfr[4];
#pragma unroll
        for (int i = 0; i < 4; ++i) af[i] = *(const bf16x8*)(sA + swz128(wm * 64 + i * 16 + fr, ch));
#pragma unroll
        for (int i = 0; i < 4; ++i) bfr[i] = *(const bf16x8*)(sB + swz128(wn * 64 + i * 16 + fr, ch));
#pragma unroll
        for (int i = 0; i < 4; ++i)
#pragma unroll
          for (int j = 0; j < 4; ++j) acc[i][j] = __builtin_amdgcn_mfma_f32_16x16x32_bf16(bfr[j], af[i], acc[i][j], 0, 0, 0);
      }
      if (kt + 1 < nk) {
        char* dA = smem + (s ^ 1) * 32768;
        char* dB = smem + 65536 + (s ^ 1) * 16384;
#pragma unroll
        for (int i = 0; i < 4; ++i) *(bf16x8*)(dA + woff + i * 8192) = ra[i];
#pragma unroll
        for (int i = 0; i < 2; ++i) *(bf16x8*)(dB + woff + i * 8192) = rb[i];
      }
      __syncthreads();
    }
#pragma unroll
    for (int i = 0; i < 4; ++i)
#pragma unroll
      for (int j = 0; j < 4; ++j) epi(m0 + wm * 64 + i * 16 + fr, n0 + wn * 64 + j * 16 + fq * 4, acc[i][j]);
  }
}

struct EpiStore {
  u16* dst; int ld; int nvalid;
  __device__ __forceinline__ void operator()(int m, int n, f32x4 v) const {
    if (n < nvalid) { u32x2 w = {cvtpk(v[0], v[1]), cvtpk(v[2], v[3])}; *(u32x2*)(dst + (size_t)m * ld + n) = w; }
  }
};
struct EpiSqRelu {
  u16* dst; int ld;
  __device__ __forceinline__ void operator()(int m, int n, f32x4 v) const {
    float a = fmaxf(v[0], 0.f), b = fmaxf(v[1], 0.f), c = fmaxf(v[2], 0.f), d = fmaxf(v[3], 0.f);
    u32x2 w = {cvtpk(a * a, b * b), cvtpk(c * c, d * d)}; *(u32x2*)(dst + (size_t)m * ld + n) = w;
  }
};
struct EpiResid {
  const Params* p; bool first; const float* gl;
  __device__ __forceinline__ void operator()(int m, int n, f32x4 v) const {
    const int midx = m < ML ? (m >> 12) : 8;
    const float4 g = *(const float4*)(gl + (size_t)midx * 6144 + n);
    const float4 r = *(const float4*)(resid_row(*p, first, m) + n);
    float4 o = make_float4(r.x + g.x * v[0], r.y + g.y * v[1], r.z + g.z * v[2], r.w + g.w * v[3]);
    *(float4*)((float*)(p->ws + OFF_XS) + (size_t)m * 1024 + n) = o;
  }
};


#define PG8_LAS __attribute__((address_space(3)))
constexpr int PG_BM = 256, PG_BK = 64, PG_HALF = 128, PG_HTB = PG_HALF * PG_BK * 2;
__device__ __forceinline__ int lds_byte(int r, int c) { const int st = (r >> 4) * 2 + (c >> 5), rr = r & 15, cc = c & 31, ob = rr * 64 + cc * 2; return st * 1024 + (ob ^ (((ob >> 9) & 1) << 5)); }
__device__ __forceinline__ void stage_rc(int b, int& R, int& C) { const int st = b / 1024, sb = b % 1024, swz = sb ^ (((sb >> 9) & 1) << 5); R = (st >> 1) * 16 + swz / 64; C = (st & 1) * 32 + (swz % 64) / 2; }
__device__ __forceinline__ int perm32(int rho) { const int n = rho >> 4, i = rho & 15; return 8 * (i >> 2) + 4 * n + (i & 3); }
struct Unit { int pm, pn; };
struct StaticOrder {
  int nM, nN, nwg, G, c;
  __device__ __forceinline__ void init(int M, int N, int G_, int c_) { nM = M / PG_BM; nN = N / PG_BM; nwg = nM * nN; G = G_; c = c_; }
  __device__ __forceinline__ bool next(int i, Unit& u) const {
    const long L = (long)i * G + c; if (L >= nwg) return false;
    int wgid = (int)L; { const int q = nwg / 8, r = nwg % 8, xcd = wgid % 8, off = wgid / 8; wgid = (xcd < r ? xcd * (q + 1) : r * (q + 1) + (xcd - r) * q) + off; }
    const int nig = 8 * nN, gid = wgid / nig, fm = gid * 8, gsz = (nM - fm) < 8 ? (nM - fm) : 8;
    u.pm = fm + ((wgid % nig) % gsz); u.pn = (wgid % nig) / gsz; return true;
  }
};
struct EpiStoreP {
  static constexpr bool PERM = true;
  u16* O; int ldc; int nvalid; int act; const float* ssq; const float* bias;
  __device__ __forceinline__ void operator()(const f32x4 (&acc)[2][2][4][2], const Unit& u, int wr, int wc, int fr, int fq) const {
    const int row0 = u.pm * PG_BM + wr * 64 + fr, col0 = u.pn * PG_BM + wc * 32 + 8 * fq;
    const int midx = (u.pm * PG_BM < ML) ? ((u.pm * PG_BM) >> 12) : 8;
    f32x4 bv[2][2];
#pragma unroll
    for (int bj = 0; bj < 2; ++bj)
#pragma unroll
      for (int n = 0; n < 2; ++n) bv[bj][n] = ssq ? *(const f32x4*)(bias + (size_t)midx * 4096 + col0 + bj * PG_HALF + 4 * n) : f32x4{0.f, 0.f, 0.f, 0.f};
    float rs[8];
    if (ssq) {
      const int lane = fr + 16 * fq;
      f32x4 sv[8];
#pragma unroll
      for (int k = 0; k < 8; ++k) sv[k] = *(const f32x4*)(ssq + (size_t)(row0 + (k >> 2) * PG_HALF + (k & 3) * 16) * 16 + fq * 4);
#pragma unroll
      for (int k = 0; k < 8; ++k) {
        float t = (sv[k][0] + sv[k][1]) + (sv[k][2] + sv[k][3]);
        t += __int_as_float(__builtin_amdgcn_ds_bpermute((lane ^ 16) << 2, __float_as_int(t)));
        t += __int_as_float(__builtin_amdgcn_ds_bpermute((lane ^ 32) << 2, __float_as_int(t)));
        rs[k] = rsqrtf(t * (1.f / 1024.f) + EPSN);
      }
    } else {
#pragma unroll
      for (int k = 0; k < 8; ++k) rs[k] = 1.f;
    }
#pragma unroll
    for (int ai = 0; ai < 2; ++ai)
#pragma unroll
      for (int m = 0; m < 4; ++m) {
        const int row = row0 + ai * PG_HALF + m * 16;
        const float rstd = rs[ai * 4 + m];
        u16* rowp = O + (size_t)row * ldc + col0;
#pragma unroll
        for (int bj = 0; bj < 2; ++bj) { f32x4 v0 = acc[ai][bj][m][0] * rstd + bv[bj][0], v1 = acc[ai][bj][m][1] * rstd + bv[bj][1];
          if (act == 1) {
#pragma unroll
            for (int q = 0; q < 4; ++q) { const float a = fmaxf(v0[q], 0.f), b = fmaxf(v1[q], 0.f); v0[q] = a * a; v1[q] = b * b; } }
          u32x4 w = {cvtpk(v0[0], v0[1]), cvtpk(v0[2], v0[3]), cvtpk(v1[0], v1[1]), cvtpk(v1[2], v1[3])};
          if (col0 + bj * PG_HALF < nvalid) *(u32x4*)(rowp + bj * PG_HALF) = w; } }
  }
};
struct EpiResidP {
  static constexpr bool PERM = true;
  const Params* p; bool first; const float* gl; bool emit; const float* gam; u16* Hout; float* ssq;
  __device__ __forceinline__ void operator()(const f32x4 (&acc)[2][2][4][2], const Unit& u, int wr, int wc, int fr, int fq) const {
    const int row0 = u.pm * PG_BM + wr * 64 + fr, col0 = u.pn * PG_BM + wc * 32 + 8 * fq;
    const int midx = (u.pm * PG_BM < ML) ? ((u.pm * PG_BM) >> 12) : 8;
    const float* gp = gl + (size_t)midx * 6144 + col0;
    const float* gmp = gam + (size_t)midx * 1024 + col0;
    const int lane = fr + 16 * fq;
    float4 gq[2][2], gmq[2][2];
#pragma unroll
    for (int bj = 0; bj < 2; ++bj)
#pragma unroll
      for (int n = 0; n < 2; ++n) {
        gq[bj][n] = *(const float4*)(gp + bj * PG_HALF + n * 4);
        gmq[bj][n] = emit ? *(const float4*)(gmp + bj * PG_HALF + n * 4) : make_float4(0.f, 0.f, 0.f, 0.f);
      }
#pragma unroll
    for (int aim = 0; aim < 4; ++aim) {
      const int ai = aim >> 1, mb = (aim & 1) * 2;
      u32x4 rwv[4][2];
      if (!first) {
#pragma unroll
        for (int m = mb; m < mb + 2; ++m) {
          const u16* op = (const u16*)(p->ws + OFF_XS) + (size_t)(row0 + ai * PG_HALF + m * 16) * 1024 + col0;
#pragma unroll
          for (int bj = 0; bj < 2; ++bj) rwv[m][bj] = *(const u32x4*)(op + bj * PG_HALF);
        }
      }
#pragma unroll
      for (int m = mb; m < mb + 2; ++m) {
        const int row = row0 + ai * PG_HALF + m * 16;
        u16* op = (u16*)(p->ws + OFF_XS) + (size_t)row * 1024 + col0;
        u16* hp = Hout + (size_t)row * 1024 + col0;
        float sq = 0.f;
#pragma unroll
        for (int bj = 0; bj < 2; ++bj) {
          float x[8], rr[8];
          if (first) {
            const float* rp = resid_row(*p, true, row) + col0;
            const float4 r0 = *(const float4*)(rp + bj * PG_HALF), r1 = *(const float4*)(rp + bj * PG_HALF + 4);
            rr[0] = r0.x; rr[1] = r0.y; rr[2] = r0.z; rr[3] = r0.w; rr[4] = r1.x; rr[5] = r1.y; rr[6] = r1.z; rr[7] = r1.w;
          } else {
            const u32x4 rw = rwv[m][bj];
#pragma unroll
            for (int q = 0; q < 4; ++q) { rr[q * 2] = bflo(rw[q]); rr[q * 2 + 1] = bfhi(rw[q]); }
          }
#pragma unroll
          for (int n = 0; n < 2; ++n) {
            const float4 g = gq[bj][n];
            const f32x4 a = acc[ai][bj][m][n];
            x[n * 4 + 0] = rr[n * 4 + 0] + g.x * a[0]; x[n * 4 + 1] = rr[n * 4 + 1] + g.y * a[1]; x[n * 4 + 2] = rr[n * 4 + 2] + g.z * a[2]; x[n * 4 + 3] = rr[n * 4 + 3] + g.w * a[3];
          }
          { u32x4 xw = {cvtpk(x[0], x[1]), cvtpk(x[2], x[3]), cvtpk(x[4], x[5]), cvtpk(x[6], x[7])}; *(u32x4*)(op + bj * PG_HALF) = xw; }
          if (emit) {
            const float4 g0 = gmq[bj][0], g1 = gmq[bj][1];
            sq += ((x[0] * x[0] + x[1] * x[1]) + (x[2] * x[2] + x[3] * x[3])) + ((x[4] * x[4] + x[5] * x[5]) + (x[6] * x[6] + x[7] * x[7]));
            u32x4 w = {cvtpk(x[0] * g0.x, x[1] * g0.y), cvtpk(x[2] * g0.z, x[3] * g0.w), cvtpk(x[4] * g1.x, x[5] * g1.y), cvtpk(x[6] * g1.z, x[7] * g1.w)};
            *(u32x4*)(hp + bj * PG_HALF) = w;
          }
        }
        if (emit) {
          sq += __int_as_float(__builtin_amdgcn_ds_bpermute((lane ^ 16) << 2, __float_as_int(sq)));
          sq += __int_as_float(__builtin_amdgcn_ds_bpermute((lane ^ 32) << 2, __float_as_int(sq)));
          if (fq == 0) ssq[(size_t)row * 16 + u.pn * 4 + wc] = sq;
        }
      }
    }
  }
};
template <class Epi>
__device__ __forceinline__ void gemm8_phase(char* smem, const u16* gA, const u16* gBt, int M, int N, int K, const Epi& E, int tid, int bid, int ldk = 0, int nks = 1) {
  PG8_LAS unsigned char* lds = (PG8_LAS unsigned char*)smem;
  if (ldk == 0) ldk = K;
  const int nNr = N / PG_BM;
  StaticOrder S; S.init(M, N * nks, gridDim.x, bid);
  const int wid = __builtin_amdgcn_readfirstlane(tid >> 6), lane = tid & 63, wr = wid >> 2, wc = wid & 3, fr = lane & 15, fq = lane >> 4;
  const int nt = K / PG_BK;
  unsigned voffA[2], voffB[2];
#pragma unroll
  for (int i = 0; i < 2; ++i) { int R, C; stage_rc(tid * 16 + i * 8192, R, C); const int Rb = Epi::PERM ? ((R & ~31) + perm32(R & 31)) : R;
    voffA[i] = (unsigned)(R * ldk + C) * 2u; voffB[i] = (unsigned)(Rb * ldk + C) * 2u; }
  const size_t kstep = (size_t)(PG_BK * 2);
  const size_t hstep = (size_t)PG_HALF * ldk * 2;
  const size_t ksb = (size_t)K * 2;
  const size_t tstep = 2 * hstep;
  const unsigned ldsw = (unsigned)wid * 1024u;
  const int aoff = lds_byte(wr * 64 + fr, fq * 8), boff = lds_byte(wc * 32 + fr, fq * 8);
#define PG8_SA(b, h) (((b) * 2 + (h)) * PG_HTB)
#define PG8_SB(b, h) ((4 + (b) * 2 + (h)) * PG_HTB)
#define PG8_STAGE(bufoff, gbase, voff) do { _Pragma("unroll") for (int _i = 0; _i < 2; ++_i) \
    __builtin_amdgcn_global_load_lds((const unsigned*)((const char*)(gbase) + (voff)[_i]), (PG8_LAS unsigned*)(lds + (bufoff) + ldsw + _i * 8192), 16, 0, 0); } while (0)
#define PG8_LDA(dst, b, h) do { _Pragma("unroll") for (int m = 0; m < 4; ++m) _Pragma("unroll") for (int k = 0; k < 2; ++k) dst[m][k] = *(const PG8_LAS bf16x8*)(lds + PG8_SA(b, h) + aoff + m * 2048 + k * 1024); } while (0)
#define PG8_LDB(dst, b, h) do { _Pragma("unroll") for (int n = 0; n < 2; ++n) _Pragma("unroll") for (int k = 0; k < 2; ++k) dst[n][k] = *(const PG8_LAS bf16x8*)(lds + PG8_SB(b, h) + boff + n * 2048 + k * 1024); } while (0)
#define PG8_MMA(ai, bj, At, Bt) do { __builtin_amdgcn_s_setprio(1); _Pragma("unroll") for (int m = 0; m < 4; ++m) _Pragma("unroll") for (int n = 0; n < 2; ++n) _Pragma("unroll") for (int k = 0; k < 2; ++k) \
    acc[ai][bj][m][n] = __builtin_amdgcn_mfma_f32_16x16x32_bf16(Bt[n][k], At[m][k], acc[ai][bj][m][n], 0, 0, 0); __builtin_amdgcn_s_setprio(0); } while (0)
#define PG8_WAIT_V(n) asm volatile("s_waitcnt vmcnt(" #n ")" ::: "memory")
#define PG8_WAIT_L(n) asm volatile("s_waitcnt lgkmcnt(" #n ")" ::: "memory")
#define PG8_BAR __builtin_amdgcn_s_barrier()
#define PG8_SCHED __builtin_amdgcn_sched_barrier(0)
  Unit cur, nxt; int ui = 0;
  if (!S.next(0, cur)) return;
  f32x4 acc[2][2][4][2];
#pragma unroll
  for (int a = 0; a < 2; ++a)
#pragma unroll
    for (int b = 0; b < 2; ++b)
#pragma unroll
      for (int m = 0; m < 4; ++m)
#pragma unroll
        for (int n = 0; n < 2; ++n) acc[a][b][m][n] = (f32x4){0.f, 0.f, 0.f, 0.f};
  bf16x8 At[4][2], B0[2][2], B1[2][2];
  const char* cA = (const char*)gA + (size_t)cur.pm * tstep + (size_t)(cur.pn / nNr) * ksb; const char* cB = (const char*)gBt + (size_t)(cur.pn % nNr) * tstep + (size_t)(cur.pn / nNr) * ksb;
  PG8_STAGE(PG8_SB(0, 0), cB, voffB); PG8_STAGE(PG8_SA(0, 0), cA, voffA); PG8_STAGE(PG8_SB(0, 1), cB + hstep, voffB); PG8_STAGE(PG8_SA(0, 1), cA + hstep, voffA);
  if (wr == 1) PG8_BAR;
  PG8_WAIT_V(4); PG8_BAR;
  PG8_STAGE(PG8_SB(1, 0), cB + kstep, voffB); PG8_STAGE(PG8_SA(1, 0), cA + kstep, voffA); PG8_STAGE(PG8_SB(1, 1), cB + hstep + kstep, voffB);
  PG8_WAIT_V(6); PG8_BAR;
  for (;;) {
    const bool has_next = S.next(ui + 1, nxt);
    const char* nA = has_next ? (const char*)gA + (size_t)nxt.pm * tstep + (size_t)(nxt.pn / nNr) * ksb : cA; const char* nB = has_next ? (const char*)gBt + (size_t)(nxt.pn % nNr) * tstep + (size_t)(nxt.pn / nNr) * ksb : cB;
    for (int t = 0; t < nt; t += 2) {
      const bool last = (t == nt - 2);
      const char* a1 = cA + (size_t)(t + 1) * kstep;
      const char* a2 = last ? nA : cA + (size_t)(t + 2) * kstep; const char* b2 = last ? nB : cB + (size_t)(t + 2) * kstep;
      const char* a3 = a2 + kstep; const char* b3 = b2 + kstep;
      PG8_LDB(B0, 0, 0); PG8_SCHED; PG8_LDA(At, 0, 0); PG8_STAGE(PG8_SA(1, 1), a1 + hstep, voffA);
      PG8_WAIT_L(8); PG8_BAR; PG8_WAIT_L(0); PG8_MMA(0, 0, At, B0); PG8_BAR; PG8_SCHED;
      PG8_LDB(B1, 0, 1); PG8_STAGE(PG8_SB(0, 0), b2, voffB);
      PG8_BAR; PG8_WAIT_L(0); PG8_MMA(0, 1, At, B1); PG8_BAR;
      PG8_LDA(At, 0, 1); PG8_STAGE(PG8_SA(0, 0), a2, voffA);
      PG8_BAR; PG8_WAIT_L(0); PG8_MMA(1, 0, At, B0); PG8_BAR; PG8_SCHED;
      PG8_STAGE(PG8_SB(0, 1), b2 + hstep, voffB);
      PG8_WAIT_V(6); PG8_BAR; PG8_MMA(1, 1, At, B1); PG8_BAR;
      PG8_LDB(B0, 1, 0); PG8_SCHED; PG8_LDA(At, 1, 0); PG8_STAGE(PG8_SA(0, 1), a2 + hstep, voffA);
      PG8_WAIT_L(8); PG8_BAR; PG8_WAIT_L(0); PG8_MMA(0, 0, At, B0); PG8_BAR; PG8_SCHED;
      PG8_LDB(B1, 1, 1); PG8_STAGE(PG8_SB(1, 0), b3, voffB);
      PG8_BAR; PG8_WAIT_L(0); PG8_MMA(0, 1, At, B1); PG8_BAR;
      PG8_LDA(At, 1, 1); PG8_STAGE(PG8_SA(1, 0), a3, voffA);
      PG8_BAR; PG8_WAIT_L(0); PG8_MMA(1, 0, At, B0); PG8_BAR; PG8_SCHED;
      PG8_STAGE(PG8_SB(1, 1), b3 + hstep, voffB);
      PG8_WAIT_V(6); PG8_BAR; PG8_MMA(1, 1, At, B1); PG8_BAR;
    }
    E(acc, cur, wr, wc, fr, fq);
    if (!has_next) break;
#pragma unroll
    for (int a = 0; a < 2; ++a)
#pragma unroll
      for (int b = 0; b < 2; ++b)
#pragma unroll
        for (int m = 0; m < 4; ++m)
#pragma unroll
          for (int n = 0; n < 2; ++n) acc[a][b][m][n] = (f32x4){0.f, 0.f, 0.f, 0.f};
    cur = nxt; cA = nA; cB = nB; ++ui;
  }
  PG8_WAIT_V(0);
  if (wr == 0) PG8_BAR;
  PG8_BAR;
#undef PG8_SA
#undef PG8_SB
#undef PG8_STAGE
#undef PG8_LDA
#undef PG8_LDB
#undef PG8_MMA
#undef PG8_WAIT_V
#undef PG8_WAIT_L
#undef PG8_BAR
#undef PG8_SCHED
}


constexpr size_t OFF_PART = OFF_S + (size_t)300000000;
struct EpiPart {
  static constexpr bool PERM = true;
  float* part;
  __device__ __forceinline__ void operator()(const f32x4 (&acc)[2][2][4][2], const Unit& u, int wr, int wc, int fr, int fq) const {
    const int ks = u.pn >> 2, pn = u.pn & 3;
    const int row0 = u.pm * PG_BM + wr * 64 + fr, col0 = pn * PG_BM + wc * 32 + 8 * fq;
#pragma unroll
    for (int ai = 0; ai < 2; ++ai)
#pragma unroll
      for (int m = 0; m < 4; ++m) {
        float* op = part + ((size_t)ks * MC + row0 + ai * PG_HALF + m * 16) * 1024 + col0;
#pragma unroll
        for (int bj = 0; bj < 2; ++bj)
#pragma unroll
          for (int n = 0; n < 2; ++n) *(f32x4*)(op + bj * PG_HALF + n * 4) = acc[ai][bj][m][n];
      }
  }
};
__device__ __forceinline__ void ctx_fix_phase(const Params& p, bool first, const float* gl8, const float* gam8, int nks, int tid, int bid) {
  const int lane = tid & 63, wid = tid >> 6;
  const float* part = (const float*)(p.ws + OFF_PART);
  u16* H = (u16*)((char*)p.out + OUT_H);
  float* ssq = (float*)((char*)p.out + OUT_SSQ);
  for (int r = bid * 8 + wid; r < MC; r += gridDim.x * 8) {
    const int row = ML + r;
    const float* rp = resid_row(p, true, row);
    u16* xo = (u16*)(p.ws + OFF_XS) + (size_t)row * 1024;
    float sq = 0.f;
    float4 av[4], rv[4], gv4[4], gmv[4];
#pragma unroll
    for (int i = 0; i < 4; ++i) {
      const int c = (lane + 64 * i) * 4;
      const float4 z = make_float4(0.f, 0.f, 0.f, 0.f);
      const float4 a0 = *(const float4*)(part + (size_t)r * 1024 + c);
      const float4 a1 = *(const float4*)(part + ((size_t)1 * MC + r) * 1024 + c);
      const float4 a2 = nks > 2 ? *(const float4*)(part + ((size_t)2 * MC + r) * 1024 + c) : z;
      const float4 a3 = nks > 2 ? *(const float4*)(part + ((size_t)3 * MC + r) * 1024 + c) : z;
      av[i] = make_float4((a0.x + a1.x) + (a2.x + a3.x), (a0.y + a1.y) + (a2.y + a3.y), (a0.z + a1.z) + (a2.z + a3.z), (a0.w + a1.w) + (a2.w + a3.w));
      gv4[i] = *(const float4*)(gl8 + c); gmv[i] = *(const float4*)(gam8 + c);
      if (first) rv[i] = *(const float4*)(rp + c);
      else { const u32x2 rw = *(const u32x2*)(xo + c); rv[i] = make_float4(bflo(rw[0]), bfhi(rw[0]), bflo(rw[1]), bfhi(rw[1])); }
    }
#pragma unroll
    for (int i = 0; i < 4; ++i) {
      const int c = (lane + 64 * i) * 4;
      const float4 a = av[i], rr = rv[i], g = gv4[i], gm = gmv[i];
      const float x0 = rr.x + g.x * a.x, x1 = rr.y + g.y * a.y, x2 = rr.z + g.z * a.z, x3 = rr.w + g.w * a.w;
      { u32x2 xw = {cvtpk(x0, x1), cvtpk(x2, x3)}; *(u32x2*)(xo + c) = xw; }
      sq += (x0 * x0 + x1 * x1) + (x2 * x2 + x3 * x3);
      u32x2 w = {cvtpk(x0 * gm.x, x1 * gm.y), cvtpk(x2 * gm.z, x3 * gm.w)};
      *(u32x2*)(H + (size_t)row * 1024 + c) = w;
    }
    sq = wave_sum(sq);
    if (lane < 16) ssq[(size_t)row * 16 + lane] = lane == 0 ? sq : 0.f;
  }
}


constexpr size_t OFF_GQB = OFF_S + (size_t)300000000;
__device__ __forceinline__ void gla_pre_phase(const Params& p, int j, char* smem, int tid, int bid) {
  float* segtot = (float*)smem;
  u16* P = (u16*)(p.ws + OFF_S);
  u16* QB = (u16*)(p.ws + OFF_GQB);
  u16* KB2 = (u16*)((char*)p.out + OUT_GKB);
  float* EBE = (float*)((char*)p.out + OUT_EBE);
  const float QSCALE = 0.08838834764831845f;
  bf16x8 wf_f, wf_b; float bias_f = 0.f, bias_b = 0.f; int h_loaded = -1;
  unsigned nqv[16], nkv[16]; bf16x8 ngqf, ngqb;
#define GPRE_LOAD(job_) do { const int h2 = (job_) & 3, rb2 = ((job_) >> 2) * 64; \
    const u16* grow = P + (size_t)(rb2 + (wid >> 2) * 32 + l32) * LDP + 3072 + hi * 8; \
    ngqf = *(const bf16x8*)(grow); ngqb = *(const bf16x8*)(grow + 16); \
    const u16* pq2 = P + (size_t)(rb2 + (wid >> 2) * 32 + 4 * hi) * LDP + h2 * 128 + (wid & 3) * 32 + l32; \
    _Pragma("unroll") for (int i = 0; i < 16; ++i) { const u16* pr = pq2 + (size_t)((i & 3) + 8 * (i >> 2)) * LDP; nqv[i] = pr[0]; nkv[i] = pr[512]; } } while (0)
  { const int lane = tid & 63, wid = tid >> 6, l32 = lane & 31, hi = lane >> 5; if (bid < 544 * 4) GPRE_LOAD(bid); }
  for (int job = bid; job < 544 * 4; job += gridDim.x) {
    asm volatile("" : "+v"(tid));
    const int lane = tid & 63, wid = tid >> 6, l32 = lane & 31, hi = lane >> 5;
    const int tbg = wid >> 2, kd = (wid & 3) * 32 + l32;
    const int h = job & 3, blk = job >> 2, rowb = blk * 64;
    if (h != h_loaded) {
      const float* wuf = p.in[11] + (size_t)j * 16 * 512 + h * 128 + kd;
      const float* wub = p.in[13] + (size_t)j * 16 * 512 + h * 128 + kd;
      float a[8], c[8];
#pragma unroll
      for (int jj = 0; jj < 8; ++jj) { a[jj] = wuf[(hi * 8 + jj) * 512]; c[jj] = wub[(hi * 8 + jj) * 512]; }
      u32x4 pa = {cvtpk(a[0], a[1]), cvtpk(a[2], a[3]), cvtpk(a[4], a[5]), cvtpk(a[6], a[7])};
      u32x4 pc = {cvtpk(c[0], c[1]), cvtpk(c[2], c[3]), cvtpk(c[4], c[5]), cvtpk(c[6], c[7])};
      wf_f = *reinterpret_cast<bf16x8*>(&pa); wf_b = *reinterpret_cast<bf16x8*>(&pc);
      bias_f = p.in[12][(size_t)j * 512 + h * 128 + kd]; bias_b = p.in[14][(size_t)j * 512 + h * 128 + kd];
      h_loaded = h;
    }
    const bf16x8 gqf = ngqf, gqb = ngqb;
    unsigned qv[16], kv[16];
#pragma unroll
    for (int i = 0; i < 16; ++i) { qv[i] = nqv[i]; kv[i] = nkv[i]; }
    u16* pq = P + (size_t)(rowb + tbg * 32 + 4 * hi) * LDP + h * 128 + kd;
    __builtin_amdgcn_sched_barrier(0);
    if (job + (int)gridDim.x < 544 * 4) GPRE_LOAD(job + (int)gridDim.x);
    __builtin_amdgcn_sched_barrier(0);
    float pf[16], pb[16], lsb[16]; float totf, totb;
    {
      f32x16 xf, xb;
#pragma unroll
      for (int r = 0; r < 16; ++r) { xf[r] = 0.f; xb[r] = 0.f; }
      xf = __builtin_amdgcn_mfma_f32_32x32x16_bf16(gqf, wf_f, xf, 0, 0, 0);
      xb = __builtin_amdgcn_mfma_f32_32x32x16_bf16(gqb, wf_b, xb, 0, 0, 0);
      float t4f[4], t4b[4];
#pragma unroll
      for (int g = 0; g < 4; ++g) {
        float cf = 0.f, cb = 0.f;
#pragma unroll
        for (int i = 0; i < 4; ++i) {
          const float x1 = xf[g * 4 + i] + bias_f, x2 = xb[g * 4 + i] + bias_b;
          const float l1 = (fminf(x1, 0.f) - flog(1.f + fexp(-fabsf(x1)))) * (1.f / 16.f);
          const float l2 = (fminf(x2, 0.f) - flog(1.f + fexp(-fabsf(x2)))) * (1.f / 16.f);
          cf += l1; cb += l2; pf[g * 4 + i] = cf; pb[g * 4 + i] = cb; lsb[g * 4 + i] = l2;
        }
        t4f[g] = cf; t4b[g] = cb;
      }
      float runf = 0.f, runb = 0.f;
#pragma unroll
      for (int g = 0; g < 4; ++g) {
        auto r1 = __builtin_amdgcn_permlane32_swap(__float_as_uint(t4f[g]), __float_as_uint(t4f[g]), false, false);
        auto r2 = __builtin_amdgcn_permlane32_swap(__float_as_uint(t4b[g]), __float_as_uint(t4b[g]), false, false);
        const float f0 = __uint_as_float(r1[0]), f1 = __uint_as_float(r1[1]), b0 = __uint_as_float(r2[0]), b1 = __uint_as_float(r2[1]);
        const float of = hi ? runf + f0 : runf, ob = hi ? runb + b0 : runb;
#pragma unroll
        for (int i = 0; i < 4; ++i) { pf[g * 4 + i] += of; pb[g * 4 + i] += ob; }
        runf += f0 + f1; runb += b0 + b1;
      }
      totf = runf; totb = runb;
    }
    if (hi == 0) { segtot[(0 * 2 + tbg) * 128 + kd] = totf; segtot[(1 * 2 + tbg) * 128 + kd] = totb; }
    __syncthreads();
    {
      const float f0 = segtot[kd], f1 = segtot[128 + kd], b0 = segtot[256 + kd], b1 = segtot[384 + kd];
      const float offf = tbg ? f0 : 0.f, offb = tbg ? b0 : 0.f;
      const float bendf = f0 + f1, bendb = b0 + b1;
      if (tbg == 0 && hi == 0) {
        EBE[(size_t)(0 * 544 + blk) * 512 + h * 128 + kd] = fexp(bendf);
        EBE[(size_t)(1 * 544 + blk) * 512 + h * 128 + kd] = fexp(bendb);
      }
      u16* pqb = QB + (size_t)(rowb + tbg * 32 + 4 * hi) * 512 + h * 128 + kd;
      u16* pkb = KB2 + (size_t)(rowb + tbg * 32 + 4 * hi) * 512 + h * 128 + kd;
#pragma unroll
      for (int i = 0; i < 16; ++i) {
        const float qf = __uint_as_float(qv[i] << 16), kf = __uint_as_float(kv[i] << 16);
        const size_t ro = (size_t)((i & 3) + 8 * (i >> 2));
        const float bf_ = pf[i] + offf;
        const float bb_ = bendb - (pb[i] + offb) + lsb[i];
        const float e1 = fexp(-bf_), e2 = fexp(-bb_);
        pq[ro * LDP] = f2bf(qf * (__builtin_amdgcn_rcpf(e1) * QSCALE));
        pq[ro * LDP + 512] = f2bf(kf * e1);
        pqb[ro * 512] = f2bf(qf * (__builtin_amdgcn_rcpf(e2) * QSCALE));
        pkb[ro * 512] = f2bf(kf * e2);
      }
    }
    __syncthreads();
  }
#undef GPRE_LOAD
}

__device__ __forceinline__ void gla_scan_phase(const Params& p, int j, bool need_ctx, char* smem, int tid, int bid) {
  const int lane = tid & 63, wid = tid >> 6, l32 = lane & 31, hi = lane >> 5;
  char* qbL = smem;
  char* kinvL = smem + 16384;
  char* kendT = smem + 32768;
  char* vT0 = smem + 49152;
  char* scL = smem + 57344;
  char* STL = smem + 65536;
  float* ebend = (float*)(smem + 81920);
  float* segtot = (float*)(smem + 82432);
  float* g16L = (float*)(smem + 84480);
  const u16* P = (const u16*)(p.ws + OFF_S);
  u16* OF = (u16*)((char*)p.out + OUT_H);
  u16* OB = (u16*)(p.ws + OFF_S + (size_t)MT * LDP * 2);
  const float QSCALE = 0.08838834764831845f;
  for (int unit = bid; unit < 256; unit += gridDim.x) {
    const int dir = unit & 1, dvs = (unit >> 1) & 3, h = (unit >> 3) & 3, b = unit >> 5;
    const int dvc = tid & 63, tg = tid >> 6;
    f32x16 Sacc;
#pragma unroll
    for (int r = 0; r < 16; ++r) Sacc[r] = 0.f;
    __syncthreads();
    { u32x4 z = {0u, 0u, 0u, 0u}; *(u32x4*)(STL + tid * 32) = z; *(u32x4*)(STL + tid * 32 + 16) = z; }
    u32x4 qx[2], kx[2]; unsigned kt[16], vv[8]; float ebv = 0.f;
    const u16* QB = (const u16*)(p.ws + OFF_GQB);
    const u16* KB2 = (const u16*)((const char*)p.out + OUT_GKB);
    const float* EBE = (const float*)((const char*)p.out + OUT_EBE);
    const u16* qsrc = dir ? QB + h * 128 : P + h * 128;
    const u16* ksrc = dir ? KB2 + h * 128 : P + 512 + h * 128;
    const long rst = dir ? 512 : LDP;
    const long sgn = dir ? -1 : 1;
#define GLA_PREFETCH(ci_) do { const int ci2 = (ci_); const bool isc = ci2 < 4; const int cc = isc ? ci2 : ci2 - 4; const int TT = isc ? CTXL : SEQL; \
      const int base = isc ? ML + b * CTXL : b * SEQL; \
      const int row0 = base + (dir ? TT - 1 - cc * 64 : cc * 64); \
      { const long ro = ((long)row0 + sgn * (tid >> 3)) * rst + (tid & 7) * 8; \
        qx[0] = *(const u32x4*)(qsrc + ro); qx[1] = *(const u32x4*)(qsrc + ro + 64); kx[0] = *(const u32x4*)(ksrc + ro); kx[1] = *(const u32x4*)(ksrc + ro + 64); } \
      { const u16* pk = ksrc + ((long)row0 + sgn * ((tid >> 7) * 8)) * rst + (tid & 127); \
        _Pragma("unroll") for (int i = 0; i < 8; ++i) { kt[i] = pk[sgn * i * rst]; kt[8 + i] = pk[sgn * (32 + i) * rst]; } } \
      { const long sst = dir ? -(long)LDP : (long)LDP; const u16* pv = P + (long)row0 * LDP + (long)(tg * 8) * sst + 1024 + h * 256 + dvs * 64 + dvc; \
        _Pragma("unroll") for (int i = 0; i < 8; ++i) vv[i] = pv[(long)i * sst]; } \
      if (tid < 128) { const int blk = (dir ? row0 - 63 : row0) >> 6; ebv = EBE[(long)(dir * 544 + blk) * 512 + h * 128 + tid]; } } while (0)
    GLA_PREFETCH(0);
    for (int ci = 0; ci < 68; ++ci) {
      asm volatile("" : "+v"(tid));
      const int lane = tid & 63, wid = tid >> 6, l32 = lane & 31, hi = lane >> 5;
      const int tbg = wid >> 2, kd = (wid & 3) * 32 + l32;
      const int dvc = tid & 63, tg = tid >> 6;
      const bool is_ctx = ci < 4; const int c = is_ctx ? ci : ci - 4; const int TT = is_ctx ? CTXL : SEQL;
      const int base = is_ctx ? ML + b * CTXL : b * SEQL;
      char* vT = vT0 + (ci & 1) * 40960;
      {
        if (tid < 128) ebend[tid] = ebv;
        const int r = tid >> 3, c0 = tid & 7;
        *(u32x4*)(qbL + swz256(r, c0)) = qx[0]; *(u32x4*)(qbL + swz256(r, c0 + 8)) = qx[1];
        *(u32x4*)(kinvL + swz256(r, c0)) = kx[0]; *(u32x4*)(kinvL + swz256(r, c0 + 8)) = kx[1];
        const int kdt = tid & 127, tgk = tid >> 7;
        u32x4 w0 = {kt[0] | (kt[1] << 16), kt[2] | (kt[3] << 16), kt[4] | (kt[5] << 16), kt[6] | (kt[7] << 16)};
        u32x4 w1 = {kt[8] | (kt[9] << 16), kt[10] | (kt[11] << 16), kt[12] | (kt[13] << 16), kt[14] | (kt[15] << 16)};
        *(u32x4*)(kendT + swz128(kdt, tgk)) = w0;
        *(u32x4*)(kendT + swz128(kdt, tgk + 4)) = w1;
        u32x4 wv = {vv[0] | (vv[1] << 16), vv[2] | (vv[3] << 16), vv[4] | (vv[5] << 16), vv[6] | (vv[7] << 16)};
        *(u32x4*)(vT + swz128(dvc, tg)) = wv;
      }
      __builtin_amdgcn_sched_barrier(0);
      if (ci + 1 < 68) GLA_PREFETCH(ci + 1);
      __builtin_amdgcn_sched_barrier(0);
      __syncthreads();
      f32x16 oacc;
#pragma unroll
      for (int r = 0; r < 16; ++r) oacc[r] = 0.f;
      const int tbo = (wid - 4) >> 1, dvbo = (wid - 4) & 1;
      if (wid < 4) {
        const int sb = wid & 1, tb = wid >> 1;
        if (sb <= tb) {
          f32x16 sacc;
#pragma unroll
          for (int r = 0; r < 16; ++r) sacc[r] = 0.f;
          bf16x8 av[8], bv8[8];
#pragma unroll
          for (int k16 = 0; k16 < 8; ++k16) {
            av[k16] = *(const bf16x8*)(kinvL + swz256(sb * 32 + l32, k16 * 2 + hi));
            bv8[k16] = *(const bf16x8*)(qbL + swz256(tb * 32 + l32, k16 * 2 + hi));
          }
#pragma unroll
          for (int k16 = 0; k16 < 8; ++k16) sacc = __builtin_amdgcn_mfma_f32_32x32x16_bf16(av[k16], bv8[k16], sacc, 0, 0, 0);
          const int t = tb * 32 + l32;
#pragma unroll
          for (int rg = 0; rg < 4; ++rg) {
            const int s0 = sb * 32 + 8 * rg + 4 * hi;
            const float v0 = (s0 + 0 <= t) ? sacc[rg * 4 + 0] : 0.f, v1 = (s0 + 1 <= t) ? sacc[rg * 4 + 1] : 0.f;
            const float v2 = (s0 + 2 <= t) ? sacc[rg * 4 + 2] : 0.f, v3 = (s0 + 3 <= t) ? sacc[rg * 4 + 3] : 0.f;
            u32x2 w = {cvtpk(v0, v1), cvtpk(v2, v3)};
            *(u32x2*)(scL + swz128(t, s0 >> 3) + (s0 & 7) * 2) = w;
          }
        }
      } else {
        bf16x8 av[8], bv8[8];
#pragma unroll
        for (int k16 = 0; k16 < 8; ++k16) {
          av[k16] = *(const bf16x8*)(qbL + swz256(tbo * 32 + l32, k16 * 2 + hi));
          bv8[k16] = *(const bf16x8*)(STL + swz256(dvbo * 32 + l32, k16 * 2 + hi));
        }
#pragma unroll
        for (int k16 = 0; k16 < 8; ++k16) oacc = __builtin_amdgcn_mfma_f32_32x32x16_bf16(av[k16], bv8[k16], oacc, 0, 0, 0);
      }
      const int kb = wid >> 1, dvb2 = wid & 1;
      {
        bf16x8 av[4], bv4[4];
#pragma unroll
        for (int k16 = 0; k16 < 4; ++k16) {
          av[k16] = *(const bf16x8*)(kendT + swz128(kb * 32 + l32, k16 * 2 + hi));
          bv4[k16] = *(const bf16x8*)(vT + swz128(dvb2 * 32 + l32, k16 * 2 + hi));
        }
#pragma unroll
        for (int k16 = 0; k16 < 4; ++k16) Sacc = __builtin_amdgcn_mfma_f32_32x32x16_bf16(av[k16], bv4[k16], Sacc, 0, 0, 0);
#pragma unroll
        for (int rg = 0; rg < 4; ++rg) {
          const f32x4 e4 = *(const f32x4*)(ebend + kb * 32 + 8 * rg + 4 * hi);
          Sacc[rg * 4 + 0] *= e4[0]; Sacc[rg * 4 + 1] *= e4[1]; Sacc[rg * 4 + 2] *= e4[2]; Sacc[rg * 4 + 3] *= e4[3];
        }
      }
      __syncthreads();
      if (wid >= 4) {
#pragma unroll
        for (int k16 = 0; k16 < 4; ++k16) {
          if (k16 < 2 || tbo == 1) {
            const bf16x8 a = *(const bf16x8*)(scL + swz128(tbo * 32 + l32, k16 * 2 + hi));
            const bf16x8 bv = *(const bf16x8*)(vT + swz128(dvbo * 32 + l32, k16 * 2 + hi));
            oacc = __builtin_amdgcn_mfma_f32_32x32x16_bf16(a, bv, oacc, 0, 0, 0);
          }
        }
        if (!is_ctx || need_ctx) {
          u16* O = dir ? OB : OF;
#pragma unroll
          for (int r = 0; r < 16; ++r) {
            const int pos = c * 64 + tbo * 32 + crow(r, hi);
            const int tok = dir ? TT - 1 - pos : pos;
            O[(size_t)(base + tok) * 1024 + h * 256 + dvs * 64 + dvbo * 32 + l32] = f2bf(oacc[r]);
          }
        }
      }
      {
        const int dv = dvb2 * 32 + l32;
#pragma unroll
        for (int rg = 0; rg < 4; ++rg) {
          const int k0 = kb * 32 + 8 * rg + 4 * hi;
          u32x2 w = {cvtpk(Sacc[rg * 4 + 0], Sacc[rg * 4 + 1]), cvtpk(Sacc[rg * 4 + 2], Sacc[rg * 4 + 3])};
          *(u32x2*)(STL + swz256(dv, k0 >> 3) + (k0 & 7) * 2) = w;
        }
      }
    }
#undef GLA_PREFETCH
    __syncthreads();
  }
}

__device__ __forceinline__ void gla_prep_phase(const Params& p, int j, int Mrows, int tid, int bid) {
  const int lane = tid & 63, wid = tid >> 6;
  const u16* P = (const u16*)(p.ws + OFF_S);
  const u16* OF = (const u16*)((char*)p.out + OUT_H);
  u16* OB = (u16*)(p.ws + OFF_GLA_OB);
  const float4 g = *(const float4*)(p.in[15] + (size_t)j * 256 + lane * 4);
  for (int row = bid * 8 + wid; row < Mrows; row += gridDim.x * 8) {
    u32x2 a[4], bq[4], rr[4];
#pragma unroll
    for (int hh = 0; hh < 4; ++hh) {
      const size_t o = (size_t)row * 1024 + hh * 256 + lane * 4;
      a[hh] = *(const u32x2*)(OF + o); bq[hh] = *(const u32x2*)(OB + o);
      rr[hh] = *(const u32x2*)(P + (size_t)row * LDP + 2048 + hh * 256 + lane * 4);
    }
#pragma unroll
    for (int hh = 0; hh < 4; ++hh) {
      const size_t o = (size_t)row * 1024 + hh * 256 + lane * 4;
      const float o0 = bflo(a[hh][0]) + bflo(bq[hh][0]), o1 = bfhi(a[hh][0]) + bfhi(bq[hh][0]), o2 = bflo(a[hh][1]) + bflo(bq[hh][1]), o3 = bfhi(a[hh][1]) + bfhi(bq[hh][1]);
      const float ss = wave_sum(o0 * o0 + o1 * o1 + o2 * o2 + o3 * o3);
      const float rstd = rsqrtf(ss * (1.f / 256.f) + EPSN);
      const float r0 = bflo(rr[hh][0]), r1 = bfhi(rr[hh][0]), r2 = bflo(rr[hh][1]), r3 = bfhi(rr[hh][1]);
      const float y0 = o0 * rstd * g.x * (r0 * sigmoidf_(r0)), y1 = o1 * rstd * g.y * (r1 * sigmoidf_(r1));
      const float y2 = o2 * rstd * g.z * (r2 * sigmoidf_(r2)), y3 = o3 * rstd * g.w * (r3 * sigmoidf_(r3));
      u32x2 w = {cvtpk(y0, y1), cvtpk(y2, y3)};
      *(u32x2*)(OB + o) = w;
    }
  }
}

constexpr size_t OFF_LRU_SUM = OFF_S + (size_t)MT * 2048 * 2;
constexpr size_t OFF_LRU_CAR = OFF_LRU_SUM + (size_t)544 * 2 * 1024 * 8;
constexpr size_t OFF_LRU_Y = OFF_LRU_CAR + (size_t)544 * 2 * 1024 * 4;
template <int PASS>
__device__ __forceinline__ void lru_tile_phase(const Params& p, int jl, int Mrows, char* smem, int tid, int bid) {
  char* xcL = smem;
  float* aL = (float*)(smem + 16384);
  float* uL = (float*)(smem + 16384 + 65536);
  const u16* P2 = (const u16*)(p.ws + OFF_S);
  u16* H = (u16*)(p.ws + OFF_LRU_Y);
  float2* summ = (float2*)(p.ws + OFF_LRU_SUM);
  const float* carry = (const float*)(p.ws + OFF_LRU_CAR);
  const u16* Wbd = (const u16*)(p.ws + OFF_WMIX) + 3072 * 1024;
  const int ntt = Mrows / 64;
  bf16x8 wb0[8], wb1[8]; float c_ba = 0.f, c_bx = 0.f, c_sp = 0.f; int n_loaded = -1;
  for (int job = bid; job < ntt * 8; job += gridDim.x) {
    asm volatile("" : "+v"(tid));
    const int lane = tid & 63, wid = tid >> 6, l32 = lane & 31, hi = lane >> 5;
    const int tt = job >> 3, n = job & 7;
    const bool lat = tt < 512;
    const int rowbase = lat ? tt * 64 : ML + (tt - 512) * 64;
    const int sloc = lat ? (tt & 63) * 64 : ((tt - 512) & 3) * 64;
    const int TT = lat ? SEQL : CTXL;
    unsigned gv[16]; float carry_in = 0.f;
    if (PASS == 2) {
      const int ch = tid & 127, tg = tid >> 7;
#pragma unroll
      for (int i = 0; i < 16; ++i) gv[i] = P2[(size_t)(rowbase + tg * 16 + i) * 2048 + n * 128 + ch];
      if (tid < 256) carry_in = carry[(size_t)(tt * 2 + (tid >> 7)) * 1024 + n * 128 + (tid & 127)];
    }
    {
      const int ch = tid & 127, tg = tid >> 7, t0 = tg * 16;
      const int col = n * 128 + ch;
      float cw0 = p.in[18][(size_t)(jl * 4 + 0) * 1024 + col], cw1 = p.in[18][(size_t)(jl * 4 + 1) * 1024 + col];
      float cw2 = p.in[18][(size_t)(jl * 4 + 2) * 1024 + col], cw3 = p.in[18][(size_t)(jl * 4 + 3) * 1024 + col];
      const float cb = p.in[19][(size_t)jl * 1024 + col];
      float xb[19]; unsigned xraw[19];
      const u16* xsrc = P2 + (size_t)(rowbase - sloc) * 2048 + 1024 + col;
#pragma unroll
      for (int i = 0; i < 19; ++i) {
        const int s = sloc + t0 + i - 2;
        const int sc = s < 0 ? 0 : (s >= TT ? TT - 1 : s);
        xraw[i] = xsrc[(size_t)sc * 2048];
      }
#pragma unroll
      for (int i = 0; i < 19; ++i) {
        const int s = sloc + t0 + i - 2;
        xb[i] = (s >= 0 && s < TT) ? __uint_as_float(xraw[i] << 16) : 0.f;
      }
#pragma unroll
      for (int i = 0; i < 16; ++i) {
        const float xc = cb + cw0 * xb[i] + cw1 * xb[i + 1] + cw2 * xb[i + 2] + cw3 * xb[i + 3];
        *(u16*)(xcL + swz256(t0 + i, ch >> 3) + (ch & 7) * 2) = f2bf(xc);
      }
    }
    __syncthreads();
    {
      const int cbk = wid & 3, dh = wid >> 2;
      const int chl = cbk * 32 + l32, col = n * 128 + chl;
      if (n != n_loaded) {
        const u16* wbase = Wbd + (size_t)n * 16384 + (size_t)chl * 128 + hi * 8;
#pragma unroll
        for (int k16 = 0; k16 < 8; ++k16) {
          wb0[k16] = *(const bf16x8*)(wbase + (size_t)(dh * 2 + 0) * 131072 + k16 * 16);
          wb1[k16] = *(const bf16x8*)(wbase + (size_t)(dh * 2 + 1) * 131072 + k16 * 16);
        }
        const float* pba = dh ? p.in[26] : p.in[21]; const float* pbx = dh ? p.in[28] : p.in[23]; const float* plam = dh ? p.in[29] : p.in[24];
        c_ba = pba[(size_t)jl * 1024 + col]; c_bx = pbx[(size_t)jl * 1024 + col];
        c_sp = -8.f * flog(1.f + fexp(-plam[(size_t)jl * 1024 + col]));
        n_loaded = n;
      }
#pragma unroll
      for (int tb = 0; tb < 2; ++tb) {
        f32x16 acc0, acc1;
#pragma unroll
        for (int r = 0; r < 16; ++r) { acc0[r] = 0.f; acc1[r] = 0.f; }
        bf16x8 af[8];
#pragma unroll
        for (int k16 = 0; k16 < 8; ++k16) af[k16] = *(const bf16x8*)(xcL + swz256(tb * 32 + l32, k16 * 2 + hi));
#pragma unroll
        for (int k16 = 0; k16 < 8; ++k16) {
          acc0 = __builtin_amdgcn_mfma_f32_32x32x16_bf16(af[k16], wb0[k16], acc0, 0, 0, 0);
          acc1 = __builtin_amdgcn_mfma_f32_32x32x16_bf16(af[k16], wb1[k16], acc1, 0, 0, 0);
        }
#pragma unroll
        for (int r = 0; r < 16; ++r) {
          const int tok = tb * 32 + crow(r, hi);
          const float xc = bf2f(*(const u16*)(xcL + swz256(tok, chl >> 3) + (chl & 7) * 2));
          const float la = c_sp * __builtin_amdgcn_rcpf(1.f + fexp(-(acc0[r] + c_ba)));
          const float ii = __builtin_amdgcn_rcpf(1.f + fexp(-(acc1[r] + c_bx)));
          const float av = fexp(la);
          aL[(dh * 64 + tok) * 128 + chl] = av;
          uL[(dh * 64 + tok) * 128 + chl] = __builtin_amdgcn_sqrtf(fmaxf(1.f - av * av, 0.f)) * (ii * xc);
        }
      }
    }
    __syncthreads();
    if (tid < 256) {
      const int dir = tid >> 7, ch = tid & 127;
      const size_t sidx = (size_t)(tt * 2 + dir) * 1024 + n * 128 + ch;
      float hst = 0.f, ap = 1.f;
      if (PASS == 2) hst = carry_in;
      const float* ap_ = aL + (dir * 64) * 128 + ch;
      float* up_ = uL + (dir * 64) * 128 + ch;
#pragma unroll 1
      for (int i0 = 0; i0 < 64; i0 += 16) {
        float av[16], uv[16];
#pragma unroll
        for (int k = 0; k < 16; ++k) { const int t = dir ? 63 - (i0 + k) : i0 + k; av[k] = ap_[t * 128]; uv[k] = up_[t * 128]; }
#pragma unroll
        for (int k = 0; k < 16; ++k) { hst = fmaf(av[k], hst, uv[k]); if (PASS == 1) ap *= av[k]; else uv[k] = hst; }
        if (PASS == 2) {
#pragma unroll
          for (int k = 0; k < 16; ++k) { const int t = dir ? 63 - (i0 + k) : i0 + k; up_[t * 128] = uv[k]; }
        }
      }
      if (PASS == 1) summ[sidx] = make_float2(ap, hst);
    }
    if (PASS == 2) {
      __syncthreads();
      const int ch = tid & 127, tg = tid >> 7;
      const int col = n * 128 + ch;
      float hsv[16];
#pragma unroll
      for (int i = 0; i < 16; ++i) { const int t = tg * 16 + i; hsv[i] = uL[(0 * 64 + t) * 128 + ch] + uL[(1 * 64 + t) * 128 + ch]; }
#pragma unroll
      for (int i = 0; i < 16; ++i) {
        const int t = tg * 16 + i;
        const float hs = hsv[i];
        const float gt = __uint_as_float(gv[i] << 16);
        const float z2 = 1.5957691216057308f * (gt + 0.044715f * gt * gt * gt);
        const float gl = gt * __builtin_amdgcn_rcpf(1.f + fexp(-z2));
        H[(size_t)(rowbase + t) * 1024 + col] = f2bf(hs * gl);
      }
    }
    __syncthreads();
  }
}

__device__ __forceinline__ void lru_carry_phase(const Params& p, int tid, int bid) {
  const int g = bid * NTHR + tid;
  if (g >= 16384) return;
  const float2* __restrict__ summ = (const float2*)(p.ws + OFF_LRU_SUM);
  float* __restrict__ carry = (float*)(p.ws + OFF_LRU_CAR);
  const int b = g >> 11, dir = (g >> 10) & 1, ch = g & 1023;
  float hst = 0.f;
#pragma unroll 1
  for (int sb = 0; sb < 68; sb += 17) {
    float2 sv[17]; size_t sidx[17];
#pragma unroll
    for (int k = 0; k < 17; ++k) {
      const int st = sb + k;
      int tt;
      if (st < 4) tt = 512 + b * 4 + (dir ? 3 - st : st);
      else tt = b * 64 + (dir ? 63 - (st - 4) : (st - 4));
      sidx[k] = (size_t)(tt * 2 + dir) * 1024 + ch;
      sv[k] = summ[sidx[k]];
    }
#pragma unroll
    for (int k = 0; k < 17; ++k) { carry[sidx[k]] = hst; hst = fmaf(sv[k].x, hst, sv[k].y); }
  }
}

constexpr size_t OFF_KB = OFF_S + (size_t)MT * 1536 * 2;
constexpr size_t OFF_VB = OFF_KB + (size_t)NBATCH * NKEY * 256 * 2;
constexpr size_t OFF_ATT_O = OFF_VB + (size_t)NBATCH * NKEY * 256 * 2;
__device__ __forceinline__ void qknorm_phase(const Params& p, int ja, int tid, int bid) {
  const int lane = tid & 63, wid = tid >> 6;
  u16* QKV = (u16*)(p.ws + OFF_S);
  u16* KB = (u16*)(p.ws + OFF_KB);
  u16* VB = (u16*)(p.ws + OFF_VB);
  const float qg1 = p.in[32][(size_t)ja * 128 + lane], qg2 = p.in[32][(size_t)ja * 128 + 64 + lane];
  const float kg1 = p.in[33][(size_t)ja * 128 + lane], kg2 = p.in[33][(size_t)ja * 128 + 64 + lane];
  const float invf = exp2f(-(float)(lane & 31) * (13.287712379549449f / 32.f));
  for (int row = bid * 8 + wid; row < MT; row += gridDim.x * 8) {
    const bool lat = row < ML;
    const int t = lat ? (row & 4095) : ((row - ML) & 255);
    const int b = lat ? (row >> 12) : ((row - ML) >> 8);
    const int key = lat ? CTXL + t : t;
    float cs = 1.f, sn = 0.f;
    if (lat) { const float pos = (float)(lane < 32 ? (t >> 6) : (t & 63)); sincosf(pos * invf, &sn, &cs); }
    u16* qr = QKV + (size_t)row * 1536;
    u16* kdst = KB + ((size_t)b * NKEY + key) * 256;
    unsigned xr1[10], xr2[10];
#pragma unroll
    for (int hs = 0; hs < 10; ++hs) { xr1[hs] = qr[hs * 128 + lane]; xr2[hs] = qr[hs * 128 + 64 + lane]; }
    const u32x2 vraw = *(const u32x2*)(qr + 1280 + lane * 4);
#pragma unroll
    for (int hs = 0; hs < 10; ++hs) {
      const float x1 = __uint_as_float(xr1[hs] << 16), x2 = __uint_as_float(xr2[hs] << 16);
      const float ss = wave_sum(x1 * x1 + x2 * x2);
      const float rstd = rsqrtf(ss * (1.f / 128.f) + EPSN);
      const float y1 = x1 * rstd * (hs < 8 ? qg1 : kg1), y2 = x2 * rstd * (hs < 8 ? qg2 : kg2);
      const float o1 = y1 * cs - y2 * sn, o2 = y1 * sn + y2 * cs;
      if (hs < 8) { qr[hs * 128 + lane] = f2bf(o1); qr[hs * 128 + 64 + lane] = f2bf(o2); }
      else { kdst[(hs - 8) * 128 + lane] = f2bf(o1); kdst[(hs - 8) * 128 + 64 + lane] = f2bf(o2); }
    }
    *(u32x2*)(VB + ((size_t)b * NKEY + key) * 256 + lane * 4) = vraw;
  }
}

constexpr int AT_LDQ = 1536, AT_LDK = 256, AT_LDO = 1024;
constexpr float AT_SCALE = 0.088388347648318440f;
constexpr float AT_THR = 8.f;
constexpr size_t SHM_V = 64 * 128 * 2, SHM_K = 64 * 128 * 2;
#define KSWZ(row, colB) ((row) * 256 + ((colB) ^ (((row) & 7) << 4)))
#define SBAR() __builtin_amdgcn_sched_barrier(0)
__device__ __forceinline__ unsigned cvtpkv(float lo, float hi) {
  unsigned r; asm volatile("v_cvt_pk_bf16_f32 %0, %1, %2" : "=v"(r) : "v"(lo), "v"(hi)); return r;
}
__device__ __forceinline__ void partialSM(f32x16& p0, f32x16& p1, float& m_reg, float& mn, float& alpha) {
  constexpr float C = AT_SCALE * 1.4426950408889634f;
  float pmax = p0[0];
#pragma unroll
  for (int r = 1; r < 16; ++r) pmax = fmaxf(pmax, p0[r]);
#pragma unroll
  for (int r = 0; r < 16; ++r) pmax = fmaxf(pmax, p1[r]);
  { auto rr = __builtin_amdgcn_permlane32_swap(__float_as_uint(pmax), __float_as_uint(pmax), false, false);
    pmax = fmaxf(__uint_as_float(rr[0]), __uint_as_float(rr[1])); }
  if (__builtin_expect(__all(pmax - m_reg <= AT_THR / AT_SCALE), 1)) { mn = m_reg; alpha = 1.f; }
  else { mn = fmaxf(m_reg, pmax); alpha = __builtin_amdgcn_exp2f((m_reg - mn) * C); m_reg = mn; }
  float mnC = -mn * C;
#pragma unroll
  for (int r = 0; r < 16; ++r) p0[r] = fmaf(p0[r], C, mnC);
#pragma unroll
  for (int r = 0; r < 16; ++r) p1[r] = fmaf(p1[r], C, mnC);
#pragma unroll
  for (int r = 0; r < 16; ++r) p0[r] = __builtin_amdgcn_exp2f(p0[r]);
}
__device__ __forceinline__ void finishSM(f32x16& p0, f32x16& p1, float alpha, float& l_reg, bf16x8& pa0, bf16x8& pa1, bf16x8& pa2, bf16x8& pa3) {
#pragma unroll
  for (int r = 0; r < 16; ++r) p1[r] = __builtin_amdgcn_exp2f(p1[r]);
  float ps = 0;
#pragma unroll
  for (int r = 0; r < 16; ++r) ps += p0[r];
#pragma unroll
  for (int r = 0; r < 16; ++r) ps += p1[r];
  { auto rr = __builtin_amdgcn_permlane32_swap(__float_as_uint(ps), __float_as_uint(ps), false, false);
    ps = __uint_as_float(rr[0]) + __uint_as_float(rr[1]); }
  l_reg = l_reg * alpha + ps;
#define PK4(P, BASE, OUT) do { unsigned a0 = cvtpkv(P[BASE + 0], P[BASE + 1]), a1 = cvtpkv(P[BASE + 2], P[BASE + 3]);   \
    unsigned b0 = cvtpkv(P[BASE + 4], P[BASE + 5]), b1 = cvtpkv(P[BASE + 6], P[BASE + 7]);                              \
    auto r0 = __builtin_amdgcn_permlane32_swap(a0, b0, false, false); auto r1 = __builtin_amdgcn_permlane32_swap(a1, b1, false, false); \
    u32x4 w = {r0[0], r1[0], r0[1], r1[1]}; OUT = *reinterpret_cast<bf16x8*>(&w); } while (0)
  PK4(p0, 0, pa0); PK4(p0, 8, pa1); PK4(p1, 0, pa2); PK4(p1, 8, pa3);
#undef PK4
}
__device__ __forceinline__ void qkt(f32x16& p0, f32x16& p1, const char* Ks, const bf16x8* qr, int r32, int hi) {
#pragma unroll
  for (int r = 0; r < 16; ++r) { p0[r] = 0.f; p1[r] = 0.f; }
#pragma unroll
  for (int d0 = 0; d0 < 8; ++d0) { int cb = (d0 * 16 + hi * 8) * 2;
    bf16x8 b0 = *reinterpret_cast<const bf16x8*>(Ks + KSWZ(r32, cb));
    bf16x8 b1 = *reinterpret_cast<const bf16x8*>(Ks + KSWZ(32 + r32, cb));
    p0 = __builtin_amdgcn_mfma_f32_32x32x16_bf16(b0, qr[d0], p0, 0, 0, 0);
    p1 = __builtin_amdgcn_mfma_f32_32x32x16_bf16(b1, qr[d0], p1, 0, 0, 0); }
}
__device__ __forceinline__ int v_st(int k, int c) { const int kk = (k & ~0xC) | ((k & 4) << 1) | ((k & 8) >> 1); return ((kk >> 3) * 4 + (c >> 5)) * 512 + ((kk & 7) * 32 + (c & 31)) * 2; }
__device__ __forceinline__ int v_rd_base(int lane) { return ((lane & 3) << 3) | (((lane >> 2) & 3) << 6) | (((lane >> 4) & 1) << 5) | (((lane >> 5) & 1) << 8); }
constexpr int v_rd_off(int d0, int ks, int half) { return d0 * 512 + ks * 4096 + half * 2048; }
template <int OFF> __device__ __forceinline__ s16x4 tr_read(int vb) {
  s16x4 r; asm volatile("ds_read_b64_tr_b16 %0, %1 offset:%2" : "=&v"(r) : "v"(vb), "i"(OFF) : "memory"); return r;
}
template <int D0> __device__ __forceinline__ void pv_one(f32x16& od, int vb, bf16x8 pa0, bf16x8 pa1, bf16x8 pa2, bf16x8 pa3) {
  const s16x4 l0 = tr_read<v_rd_off(D0, 0, 0)>(vb), h0 = tr_read<v_rd_off(D0, 0, 1)>(vb), l1 = tr_read<v_rd_off(D0, 1, 0)>(vb), h1 = tr_read<v_rd_off(D0, 1, 1)>(vb);
  const s16x4 l2 = tr_read<v_rd_off(D0, 2, 0)>(vb), h2 = tr_read<v_rd_off(D0, 2, 1)>(vb), l3 = tr_read<v_rd_off(D0, 3, 0)>(vb), h3 = tr_read<v_rd_off(D0, 3, 1)>(vb);
  asm volatile("s_waitcnt lgkmcnt(0)" ::: "memory"); SBAR();
#define PK(L, H) (bf16x8){L[0], L[1], L[2], L[3], H[0], H[1], H[2], H[3]}
  od = __builtin_amdgcn_mfma_f32_32x32x16_bf16(pa0, PK(l0, h0), od, 0, 0, 0);
  od = __builtin_amdgcn_mfma_f32_32x32x16_bf16(pa1, PK(l1, h1), od, 0, 0, 0);
  od = __builtin_amdgcn_mfma_f32_32x32x16_bf16(pa2, PK(l2, h2), od, 0, 0, 0);
  od = __builtin_amdgcn_mfma_f32_32x32x16_bf16(pa3, PK(l3, h3), od, 0, 0, 0);
#undef PK
}
__device__ __forceinline__ void pv_d0(f32x16* o, int vb, bf16x8 pa0, bf16x8 pa1, bf16x8 pa2, bf16x8 pa3) {
  pv_one<0>(o[0], vb, pa0, pa1, pa2, pa3); pv_one<1>(o[1], vb, pa0, pa1, pa2, pa3); pv_one<2>(o[2], vb, pa0, pa1, pa2, pa3); pv_one<3>(o[3], vb, pa0, pa1, pa2, pa3);
}
__device__ __forceinline__ void attn_dense_body(const u16* __restrict__ Qb, const u16* __restrict__ Kh, const u16* __restrict__ Vh,
                                                u16* __restrict__ Ob, int seq, char* lds, int tid) {
  const int wid = tid >> 6, lane = tid & 63, r32 = lane & 31, hi = lane >> 5;
  char* V_lds = lds; char* K_lds = lds + 2 * SHM_V;
  float* wsl = (float*)(lds + 2 * SHM_V + 2 * SHM_K) + wid * 64; float* li_l = wsl; float* al_l = wsl + 32;
  float m_reg = -1e30f, l_reg = 0; f32x16 o[4]; bf16x8 qr[8];
#pragma unroll
  for (int d = 0; d < 4; ++d)
#pragma unroll
    for (int r = 0; r < 16; ++r) o[d][r] = 0.f;
  const u16* Qw = Qb + (long)(wid * 32 + r32) * AT_LDQ + hi * 8;
#pragma unroll
  for (int d0 = 0; d0 < 8; ++d0) qr[d0] = *reinterpret_cast<const bf16x8*>(Qw + d0 * 16);
  const int sr = tid >> 4, sc = (tid & 15) * 8, vst0 = v_st(sr, sc), vst1 = v_st(32 + sr, sc);
  const int vb0 = (int)(uintptr_t)V_lds + v_rd_base(lane);
  struct { bf16x8 vs0, vs1, ks0, ks1; } sr_[2];
#define SLOAD(i, k0) do { sr_[i].vs0 = *(const bf16x8*)(&Vh[(long)((k0) + sr) * AT_LDK + sc]); sr_[i].vs1 = *(const bf16x8*)(&Vh[(long)((k0) + 32 + sr) * AT_LDK + sc]); \
    sr_[i].ks0 = *(const bf16x8*)(&Kh[(long)((k0) + sr) * AT_LDK + sc]); sr_[i].ks1 = *(const bf16x8*)(&Kh[(long)((k0) + 32 + sr) * AT_LDK + sc]); } while (0)
#define SWRITE(b, i) do { *(bf16x8*)(V_lds + (b) * SHM_V + vst0) = sr_[i].vs0;          \
    *(bf16x8*)(V_lds + (b) * SHM_V + vst1) = sr_[i].vs1; int kc = sc * 2;               \
    *(bf16x8*)(K_lds + (b) * SHM_K + KSWZ(sr, kc)) = sr_[i].ks0;                       \
    *(bf16x8*)(K_lds + (b) * SHM_K + KSWZ(32 + sr, kc)) = sr_[i].ks1; } while (0)
#define SWAIT() asm volatile("s_waitcnt vmcnt(4)" ::: "memory")
#define RESC(a) do { if (__any((a) < 1.f)) { if (hi == 0) al_l[r32] = (a); asm volatile("s_waitcnt lgkmcnt(0)" ::: "memory"); \
    for (int d = 0; d < 4; ++d) for (int r = 0; r < 16; ++r) o[d][r] *= al_l[crow(r, hi)]; } } while (0)
  f32x16 pA0, pA1, pB0, pB1; float mnA, mnB, alA, alB; bf16x8 pa0, pa1, pa2, pa3; const int NT = seq / 64;
  constexpr int SE = 0, SO = 1;
  SLOAD(SE, 0); asm volatile("s_waitcnt vmcnt(0)" ::: "memory"); SWRITE(0, SE); __syncthreads();
  qkt(pA0, pA1, K_lds, qr, r32, hi); partialSM(pA0, pA1, m_reg, mnA, alA);
  SLOAD(SO, 64); if (2 < NT) SLOAD(SE, 2 * 64);
  SWAIT(); SWRITE(1, SO); __syncthreads();
  for (int j = 1; j + 1 < NT; j += 2) {
    SBAR(); qkt(pB0, pB1, K_lds + SHM_K, qr, r32, hi);
    finishSM(pA0, pA1, alA, l_reg, pa0, pa1, pa2, pa3); SBAR();
    SLOAD(SO, (j + 2) * 64); SBAR();
    pv_d0(o, vb0, pa0, pa1, pa2, pa3); partialSM(pB0, pB1, m_reg, mnB, alB);
    __syncthreads(); SWAIT(); SWRITE(0, SE);
    RESC(alB); __syncthreads();
    SBAR(); qkt(pA0, pA1, K_lds, qr, r32, hi);
    finishSM(pB0, pB1, alB, l_reg, pa0, pa1, pa2, pa3); SBAR();
    if (j + 3 < NT) SLOAD(SE, (j + 3) * 64); SBAR();
    pv_d0(o, vb0 + (int)SHM_V, pa0, pa1, pa2, pa3); partialSM(pA0, pA1, m_reg, mnA, alA);
    __syncthreads(); SWAIT(); SWRITE(1, SO);
    RESC(alA); __syncthreads();
  }
  SBAR(); qkt(pB0, pB1, K_lds + SHM_K, qr, r32, hi);
  finishSM(pA0, pA1, alA, l_reg, pa0, pa1, pa2, pa3); SBAR();
  pv_d0(o, vb0, pa0, pa1, pa2, pa3); partialSM(pB0, pB1, m_reg, mnB, alB);
  __syncthreads(); RESC(alB);
  finishSM(pB0, pB1, alB, l_reg, pa0, pa1, pa2, pa3); SBAR();
  pv_d0(o, vb0 + (int)SHM_V, pa0, pa1, pa2, pa3);
  if (hi == 0) li_l[r32] = l_reg; asm volatile("s_waitcnt lgkmcnt(0)" ::: "memory");
  float rli[16];
#pragma unroll
  for (int r = 0; r < 16; ++r) rli[r] = __builtin_amdgcn_rcpf(li_l[crow(r, hi)]);
  u16* Ow = Ob + (long)(wid * 32) * AT_LDO;
#pragma unroll
  for (int r = 0; r < 16; ++r) { int orow = crow(r, hi);
#pragma unroll
    for (int d0 = 0; d0 < 4; ++d0) Ow[(long)orow * AT_LDO + d0 * 32 + r32] = f2bf(o[d0][r] * rli[r]); }
#undef SLOAD
#undef SWRITE
#undef SWAIT
#undef RESC
}

__device__ __forceinline__ void attn_phase(const Params& p, bool need_ctx, char* smem, int tid, int bid) {
  const u16* QKV = (const u16*)(p.ws + OFF_S);
  const u16* KB = (const u16*)(p.ws + OFF_KB);
  const u16* VB = (const u16*)(p.ws + OFF_VB);
  u16* H = (u16*)(p.ws + OFF_ATT_O);
  const int NU = need_ctx ? 1088 : 1024;
  for (int it = bid; it < NU; it += gridDim.x) {
    asm volatile("" : "+v"(tid));
    const int v = it < 1024 ? (it & 7) * 128 + (it >> 3) : it;
    int b, h, row0, seq;
    if (v < 1024) { b = v >> 7; const int kvh = (v >> 6) & 1, rest = v & 63; h = kvh * 4 + (rest & 3); row0 = b * SEQL + (rest >> 2) * 256; seq = NKEY; }
    else { const int c = v - 1024; b = c >> 3; h = c & 7; row0 = ML + b * CTXL; seq = CTXL; }
    const int kvh = h >> 2;
    attn_dense_body(QKV + (size_t)row0 * 1536 + h * 128, KB + (size_t)b * NKEY * 256 + kvh * 128, VB + (size_t)b * NKEY * 256 + kvh * 128,
                    H + (size_t)row0 * 1024 + h * 128, seq, smem, tid);
    __syncthreads();
  }
}

enum { OP_MOD = 0, OP_N1, OP_IN, OP_GSCAN, OP_GPREP, OP_OUT, OP_N2, OP_UP, OP_DOWN, OP_LP1, OP_LCAR, OP_LP2, OP_QKN, OP_ATT, OP_FINAL, OP_CFIX1, OP_CFIX2, OP_GPRE };
constexpr int NPHASE = 36;
constexpr int PROBE_OP = -1, PROBE_REP = 1, PROBE_XBAR = 0;
__device__ __forceinline__ void decode_phase(int ph, int& layer, int& op) {
  if (ph == 0) { layer = 0; op = OP_MOD; return; }
  if (ph == NPHASE - 1) { layer = 3; op = OP_FINAL; return; }
  int q = ph - 1;
  if (q < 10) { layer = 0; op = q == 0 ? OP_N1 : q == 1 ? OP_IN : q == 2 ? OP_GPRE : q == 3 ? OP_GSCAN : q == 4 ? OP_GPREP : q == 5 ? OP_OUT : q == 6 ? OP_CFIX1 : q == 7 ? OP_UP : q == 8 ? OP_DOWN : OP_CFIX2; }
  else if (q < 19) { layer = 1; q -= 10; op = q == 0 ? OP_IN : q == 1 ? OP_LP1 : q == 2 ? OP_LCAR : q == 3 ? OP_LP2 : q == 4 ? OP_OUT : q == 5 ? OP_CFIX1 : q == 6 ? OP_UP : q == 7 ? OP_DOWN : OP_CFIX2; }
  else if (q < 27) { layer = 2; q -= 19; op = q == 0 ? OP_IN : q == 1 ? OP_QKN : q == 2 ? OP_ATT : q == 3 ? OP_OUT : q == 4 ? OP_CFIX1 : q == 5 ? OP_UP : q == 6 ? OP_DOWN : OP_CFIX2; }
  else { layer = 3; q -= 27; op = q == 0 ? OP_IN : q == 1 ? OP_GPRE : q == 2 ? OP_GSCAN : q == 3 ? OP_GPREP : q == 4 ? OP_OUT : q == 5 ? OP_UP : OP_DOWN; }
}

#define XB_XCNT(j)  (256  + 64 * (j))
#define XB_XSUB(j)  (1280 + 64 * (j))
#define XB_XGEN(j)  (2304 + 64 * (j))
#define XB_TOP      3328
#define XB_TOPGEN   3392
#define XB_WORDS    3456
__device__ __forceinline__ unsigned xb_ld(unsigned* p) { return __hip_atomic_load(p, __ATOMIC_RELAXED, __HIP_MEMORY_SCOPE_AGENT); }
__device__ __forceinline__ unsigned xb_add(unsigned* p, unsigned v) { return __hip_atomic_fetch_add(p, v, __ATOMIC_RELAXED, __HIP_MEMORY_SCOPE_AGENT); }
__device__ __forceinline__ unsigned xb_xcc_id() { return (unsigned)__builtin_amdgcn_s_getreg((3 << 11) | 20) & 0xFu; }
__device__ __forceinline__ void grid_barrier(unsigned* bar, volatile unsigned* st) {
  asm volatile("s_waitcnt vmcnt(0)" ::: "memory");
  __syncthreads();
  if (threadIdx.x == 0) {
    __builtin_amdgcn_s_waitcnt(0);
    const unsigned x = st[2], nloc = st[0], nx = st[1];
    const unsigned old = xb_add(&bar[XB_XSUB(x)], 1u);
    const unsigned gen = old / nloc;
    if (old + 1u == (gen + 1u) * nloc) {
      __builtin_amdgcn_fence(__ATOMIC_RELEASE, "agent");
      asm volatile("s_waitcnt vmcnt(0)" ::: "memory");
      const unsigned og = xb_add(&bar[XB_TOP], 1u);
      const unsigned tg = og / nx;
      if (og + 1u == (tg + 1u) * nx) xb_add(&bar[XB_TOPGEN], 1u);
      else { while (xb_ld(&bar[XB_TOPGEN]) == tg) __builtin_amdgcn_s_sleep(1); }
      __builtin_amdgcn_fence(__ATOMIC_ACQUIRE, "agent");
      xb_add(&bar[XB_XGEN(x)], 1u);
      asm volatile("s_waitcnt vmcnt(0)" ::: "memory");
    } else {
      while (xb_ld(&bar[XB_XGEN(x)]) == gen) __builtin_amdgcn_s_sleep(1);
      __builtin_amdgcn_fence(__ATOMIC_ACQUIRE, "agent");
      asm volatile("s_waitcnt vmcnt(0)" ::: "memory");
    }
  }
  __syncthreads();
}

__global__ void __launch_bounds__(NTHR) fwd_megakernel(Params p, int ph_lo, int ph_hi) {
  extern __shared__ __attribute__((aligned(16))) char smem[];
  cg::grid_group grid = cg::this_grid();
  u16* H = (u16*)((char*)p.out + OUT_H);
  u16* S = (u16*)(p.ws + OFF_S);
  u16* WM = (u16*)(p.ws + OFF_WMIX);
  u16* WP = (u16*)(p.ws + OFF_WMLP);
  const float* mod = (const float*)(p.ws + OFF_MOD);
  unsigned nbar = 0; bool replayed = false;
  unsigned* bar = (unsigned*)(p.ws + OFF_BAR);
  volatile unsigned* xst = (volatile unsigned*)(smem + SMEM_BYTES);
  bool census_done = false;
  if (threadIdx.x == 0) { const unsigned x = xb_xcc_id(); xst[2] = x; xb_add(&bar[XB_XCNT(x)], 1u); }
  for (int ph = ph_lo; ph < ph_hi; ++ph) {
    int layer, op;
    decode_phase(ph, layer, op);
    int tid = threadIdx.x; asm volatile("" : "+v"(tid));
    int bid = blockIdx.x; asm volatile("" : "+s"(bid));
    const int kind = layer % 3, jj = layer / 3;
    const bool need_ctx = layer < 3;
    const int Mout = need_ctx ? MT : ML;
    switch (op) {
      case OP_MOD: mod_phase(p, smem, tid, bid); break;
      case OP_N1: norm_phase(p, layer, 0, MT, tid, bid); __syncthreads(); cvt_layer(p, 0, smem, tid, bid, (int)gridDim.x, true, true); __syncthreads(); bias_phase(p, smem, tid, bid); break;
      case OP_IN:
        { const int Nn = kind == 0 ? 3328 : kind == 1 ? 2048 : 1536, ldo = kind == 0 ? LDP : Nn;
          const float* bi = (const float*)((char*)p.out + OUT_BIAS) + (size_t)((layer * 2 + 0) * 9) * 4096;
          gemm8_phase(smem, H, WM, MT, Nn, 1024, EpiStoreP{S, ldo, ldo, 0, layer == 0 ? (const float*)nullptr : (const float*)((char*)p.out + OUT_SSQ), bi}, tid, bid);
          if (layer > 0) { __syncthreads();
            const int skip = (gridDim.x == 256) ? (kind == 1 ? 64 : kind == 2 ? 48 : 0) : 0;
            cvt_layer(p, layer, smem, tid, bid < skip ? -1 : bid - skip, (int)gridDim.x - skip, false, true); } }
        break;
      case OP_GPRE: gla_pre_phase(p, jj, smem, tid, bid); break;
      case OP_GSCAN: gla_scan_phase(p, jj, need_ctx, smem, tid, bid); break;
      case OP_GPREP: gla_prep_phase(p, jj, Mout, tid, bid); break;
      case OP_OUT: {
        const u16* wo = WM + (kind == 0 ? 3328 * 1024 : kind == 1 ? 2048 * 1024 : 1536 * 1024);
        const u16* Ya = (const u16*)(p.ws + (kind == 0 ? OFF_GLA_OB : kind == 1 ? OFF_LRU_Y : OFF_ATT_O));
        const float* gm = (const float*)((char*)p.out + OUT_GAM) + (size_t)((layer * 2 + 1) * 9) * 1024;
        gemm8_phase(smem, Ya, wo, ML, 1024, 1024, EpiResidP{&p, layer == 0, mod + (size_t)layer * 9 * 6144 + 2048, true, gm, H, (float*)((char*)p.out + OUT_SSQ)}, tid, bid);
        if (layer < 3) gemm8_phase(smem, Ya + (size_t)ML * 1024, wo, MC, 1024, 512, EpiPart{(float*)(p.ws + OFF_PART)}, tid, bid, 1024, 2);
      } break;
      case OP_CFIX1: ctx_fix_phase(p, layer == 0, mod + (size_t)(layer * 9 + 8) * 6144 + 2048, (const float*)((char*)p.out + OUT_GAM) + (size_t)((layer * 2 + 1) * 9 + 8) * 1024, 2, tid, bid); break;
      case OP_CFIX2: ctx_fix_phase(p, false, mod + (size_t)(layer * 9 + 8) * 6144 + 5120, (const float*)((char*)p.out + OUT_GAM) + (size_t)(((layer + 1) * 2 + 0) * 9 + 8) * 1024, 4, tid, bid); break;
      case OP_UP: {
        const float* bi = (const float*)((char*)p.out + OUT_BIAS) + (size_t)((layer * 2 + 1) * 9) * 4096;
        gemm8_phase(smem, H, WP, Mout, 4096, 1024, EpiStoreP{S, 4096, 4096, 1, (const float*)((char*)p.out + OUT_SSQ), bi}, tid, bid);
        if (layer < 3) { __syncthreads();
          const int skip = (gridDim.x == 256) ? 128 : 0;
          cvt_layer(p, layer + 1, smem, tid, bid < skip ? -1 : bid - skip, (int)gridDim.x - skip, true, false); }
      } break;
      case OP_DOWN: {
        const int ln = layer < 3 ? layer + 1 : 3;
        const float* gm = (const float*)((char*)p.out + OUT_GAM) + (size_t)((ln * 2 + 0) * 9) * 1024;
        gemm8_phase(smem, S, WP + 4096 * 1024, ML, 1024, 4096, EpiResidP{&p, false, mod + (size_t)layer * 9 * 6144 + 5120, layer < 3, gm, H, (float*)((char*)p.out + OUT_SSQ)}, tid, bid);
        if (layer < 3) {
          gemm8_phase(smem, S + (size_t)ML * 4096, WP + 4096 * 1024, MC, 1024, 1024, EpiPart{(float*)(p.ws + OFF_PART)}, tid, bid, 4096, 4);
        }
      } break;
      case OP_LP1: lru_tile_phase<1>(p, jj, MT, smem, tid, bid); break;
      case OP_LCAR: lru_carry_phase(p, tid, bid); break;
      case OP_LP2: lru_tile_phase<2>(p, jj, Mout, smem, tid, bid); break;
      case OP_QKN: qknorm_phase(p, jj, tid, bid); break;
      case OP_ATT: attn_phase(p, need_ctx, smem, tid, bid); break;
      case OP_FINAL: final_norm_phase(p, tid, bid); break;
    }
    if (ph + 1 < ph_hi) {
      if (!census_done) {
        grid.sync();
        if (threadIdx.x == 0) {
          const unsigned x = xst[2]; unsigned cnt = 0u, mine = 1u;
          for (unsigned jx = 0; jx < 16; ++jx) { const unsigned c = xb_ld(&bar[XB_XCNT(jx)]); cnt += (c > 0u) ? 1u : 0u; if (jx == x) mine = c; }
          xst[0] = mine; xst[1] = cnt;
        }
        __syncthreads();
        census_done = true;
      } else {
        for (int xb = 0; xb < PROBE_XBAR; ++xb) grid_barrier(bar, xst);
        grid_barrier(bar, xst);
      }
    }
    if (PROBE_REP > 1 && op == PROBE_OP && !replayed) { replayed = true; --ph; } else replayed = false;
  }
}

extern "C" void kernel_launch(void* const* d_in, const int* in_sizes, int n_in, void* d_out, int out_size, void* d_ws, size_t ws_size,
                              hipStream_t stream) {
  static int grid_blocks = 0;
  if (!grid_blocks) {
    int dev = 0, cus = 0, per_cu = 0;
    (void)hipGetDevice(&dev);
    (void)hipDeviceGetAttribute(&cus, hipDeviceAttributeMultiprocessorCount, dev);
    (void)hipFuncSetAttribute((const void*)fwd_megakernel, hipFuncAttributeMaxDynamicSharedMemorySize, SMEM_BYTES + 16);
    (void)hipOccupancyMaxActiveBlocksPerMultiprocessor(&per_cu, fwd_megakernel, NTHR, SMEM_BYTES + 16);
    if (per_cu < 1) per_cu = 1;
    if (per_cu > 1) per_cu = 1;
    grid_blocks = cus * per_cu;
    if (ws_size < WS_NEED || (size_t)out_size * 4 < OUT_END2) fprintf(stderr, "workspace too small: %zu < %zu\n", ws_size, (size_t)WS_NEED);
  }
  if (n_in < 36) return;
  Params p{};
  for (int i = 0; i < 36; ++i) p.in[i] = (const float*)d_in[i];
  p.out = (float*)d_out;
  p.ws = (char*)d_ws;
  (void)hipMemsetAsync((char*)d_ws + OFF_BAR, 0, 16384, stream);
  int lo = 0, hi = NPHASE;
  void* args[] = {&p, &lo, &hi};
  hipError_t e = hipLaunchCooperativeKernel((void*)fwd_megakernel, dim3(grid_blocks), dim3(NTHR), args, SMEM_BYTES + 16, stream);
  if (e != hipSuccess) fprintf(stderr, "cooperative launch failed: %s (grid %d)\n", hipGetErrorString(e), grid_blocks);
}
```

```cpp
#include <hip/hip_runtime.h>
#include <hip/hip_cooperative_groups.h>
#include <cstdio>
#include <cstdint>
namespace cg = cooperative_groups;

typedef unsigned short u16;
typedef __attribute__((ext_vector_type(8))) short bf16x8;
typedef __attribute__((ext_vector_type(4))) short s16x4;
typedef __attribute__((ext_vector_type(4))) float f32x4;
typedef __attribute__((ext_vector_type(16))) float f32x16;
typedef __attribute__((ext_vector_type(4))) unsigned u32x4;
typedef __attribute__((ext_vector_type(2))) unsigned u32x2;

constexpr int NTHR = 512;
constexpr int DM = 1024, NBATCH = 8, SEQL = 4096, CTXL = 256;
constexpr int ML = NBATCH * SEQL;
constexpr int MC = NBATCH * CTXL;
constexpr int MT = ML + MC;
constexpr float EPSN = 1e-6f;
constexpr int LDP = 3104;
constexpr int NKEY = CTXL + SEQL;

constexpr size_t OFF_XS   = 0;
constexpr size_t OFF_WMIX = OFF_XS + (size_t)MT * 1024 * 4;
constexpr size_t OFF_WMLP = OFF_WMIX + 9437184;
constexpr size_t OFF_MOD  = OFF_WMLP + 16777216;
constexpr size_t OFF_BAR  = OFF_MOD + 884736;
constexpr size_t OFF_S    = OFF_BAR + 16384;
constexpr size_t OUT_GAM  = 0;
constexpr size_t OUT_BIAS = OUT_GAM + 4 * 2 * 9 * 1024 * 4;
constexpr size_t OUT_SSQ  = OUT_BIAS + 4 * 2 * 9 * 4096 * 4;
constexpr size_t OUT_H    = OUT_SSQ + (size_t)MT * 16 * 4;
constexpr size_t OUT_END  = OUT_H + (size_t)MT * 1024 * 2;
constexpr size_t OUT_GKB  = OUT_END;
constexpr size_t OUT_EBE  = OUT_GKB + (size_t)MT * 512 * 2;
constexpr size_t OUT_END2 = OUT_EBE + (size_t)2 * 544 * 512 * 4;
constexpr size_t WS_NEED  = OFF_S + (size_t)300000000 + (size_t)MT * 512 * 2;
constexpr size_t OFF_GLA_OB = OFF_S + (size_t)MT * LDP * 2;
constexpr int SMEM_BYTES = 147456;

struct Params {
  const float* in[36];
  float* out;
  char* ws;
};

__device__ __forceinline__ unsigned cvtpk(float lo, float hi) {
  unsigned r; asm("v_cvt_pk_bf16_f32 %0, %1, %2" : "=v"(r) : "v"(lo), "v"(hi)); return r;
}
__device__ __forceinline__ u16 f2bf(float x) { return (u16)(cvtpk(x, 0.f) & 0xffffu); }
__device__ __forceinline__ float bf2f(u16 x) { return __uint_as_float(((unsigned)x) << 16); }
__device__ __forceinline__ float bflo(unsigned w) { return __uint_as_float(w << 16); }
__device__ __forceinline__ float bfhi(unsigned w) { return __uint_as_float(w & 0xffff0000u); }
__device__ __forceinline__ float wave_sum_l(float v, int lane) {
#pragma unroll
  for (int o = 32; o > 0; o >>= 1) v += __int_as_float(__builtin_amdgcn_ds_bpermute((lane ^ o) << 2, __float_as_int(v)));
  return v;
}
#define wave_sum(v) wave_sum_l((v), lane)
__device__ __forceinline__ float fexp(float x) { return __builtin_amdgcn_exp2f(x * 1.4426950408889634f); }
__device__ __forceinline__ float flog(float x) { return __builtin_amdgcn_logf(x) * 0.6931471805599453f; }
__device__ __forceinline__ float sigmoidf_(float x) { return __builtin_amdgcn_rcpf(1.f + fexp(-x)); }
__device__ __forceinline__ int swz128(int row, int chunk) { return row * 128 + ((chunk ^ ((row >> 1) & 7)) << 4); }
__device__ __forceinline__ int swz256(int row, int chunk) { return row * 256 + ((chunk ^ (row & 15)) << 4); }
__device__ __forceinline__ int crow(int r, int hi) { return (r & 3) + 8 * (r >> 2) + 4 * hi; }

__device__ __forceinline__ const float* resid_row(const Params& p, bool first, int row) {
  if (!first) return (const float*)(p.ws + OFF_XS) + (size_t)row * 1024;
  return row < ML ? p.in[0] + (size_t)row * 1024 : p.in[2] + (size_t)(row - ML) * 1024;
}

__device__ __forceinline__ void cvt_matrix(const float* __restrict__ src, int ldsrc, int K, int Nsrc, int Npad,
                                           u16* __restrict__ dst, int& ctr, float* tl, int tid, int bid, int G) {
  const int nn = Npad / 64, T = (K / 64) * nn;
  int first = ((bid - ctr) % G + G) % G;
  if (bid < 0) first = T;
  for (int t = first; t < T; t += G) {
    const int k0 = (t / nn) * 64, n0 = (t % nn) * 64;
    {
      const int r = tid >> 4, c4 = (tid & 15) * 4;
#pragma unroll
      for (int i = 0; i < 2; ++i) {
        const int rr = r + 32 * i;
        float4 v = make_float4(0.f, 0.f, 0.f, 0.f);
        if (n0 + c4 < Nsrc) v = *(const float4*)(src + (size_t)(k0 + rr) * ldsrc + n0 + c4);
        float* d = tl + rr * 65 + c4;
        d[0] = v.x; d[1] = v.y; d[2] = v.z; d[3] = v.w;
      }
    }
    __syncthreads();
    {
      const int n = tid >> 3, k8 = (tid & 7) * 8;
      float f[8];
#pragma unroll
      for (int i = 0; i < 8; ++i) f[i] = tl[(k8 + i) * 65 + n];
      u32x4 w = {cvtpk(f[0], f[1]), cvtpk(f[2], f[3]), cvtpk(f[4], f[5]), cvtpk(f[6], f[7])};
      *(u32x4*)(dst + (size_t)(n0 + n) * K + k0 + k8) = w;
    }
    __syncthreads();
  }
  ctr += T;
}

__device__ __forceinline__ void cvt_layer(const Params& p, int l, char* smem, int tid, int bid, int G, bool do_mix, bool do_mlp) {
  int ctr = 0; float* tl = (float*)smem;
  const int kind = l % 3, j = l / 3;
  u16* wm = (u16*)(p.ws + OFF_WMIX);
  u16* wp = (u16*)(p.ws + OFF_WMLP);
  if (do_mix) {
  if (kind == 0) {
    cvt_matrix(p.in[10] + (size_t)j * 1024 * 3104, 3104, 1024, 3104, 3328, wm, ctr, tl, tid, bid, G);
    cvt_matrix(p.in[16] + (size_t)j * 1024 * 1024, 1024, 1024, 1024, 1024, wm + 3328 * 1024, ctr, tl, tid, bid, G);
  } else if (kind == 1) {
    cvt_matrix(p.in[17] + (size_t)j * 1024 * 2048, 2048, 1024, 2048, 2048, wm, ctr, tl, tid, bid, G);
    cvt_matrix(p.in[30] + (size_t)j * 1024 * 1024, 1024, 1024, 1024, 1024, wm + 2048 * 1024, ctr, tl, tid, bid, G);
    u16* wb = wm + 3072 * 1024;
    for (int n = 0; n < 8; ++n) {
      cvt_matrix(p.in[20] + (size_t)(j * 8 + n) * 16384, 128, 128, 128, 128, wb + (0 * 8 + n) * 16384, ctr, tl, tid, bid, G);
      cvt_matrix(p.in[22] + (size_t)(j * 8 + n) * 16384, 128, 128, 128, 128, wb + (1 * 8 + n) * 16384, ctr, tl, tid, bid, G);
      cvt_matrix(p.in[25] + (size_t)(j * 8 + n) * 16384, 128, 128, 128, 128, wb + (2 * 8 + n) * 16384, ctr, tl, tid, bid, G);
      cvt_matrix(p.in[27] + (size_t)(j * 8 + n) * 16384, 128, 128, 128, 128, wb + (3 * 8 + n) * 16384, ctr, tl, tid, bid, G);
    }
  } else {
    cvt_matrix(p.in[31] + (size_t)j * 1024 * 1536, 1536, 1024, 1536, 1536, wm, ctr, tl, tid, bid, G);
    cvt_matrix(p.in[34] + (size_t)j * 1024 * 1024, 1024, 1024, 1024, 1024, wm + 1536 * 1024, ctr, tl, tid, bid, G);
  }
  }
  if (do_mlp) {
  cvt_matrix(p.in[8] + (size_t)l * 1024 * 4096, 4096, 1024, 4096, 4096, wp, ctr, tl, tid, bid, G);
  cvt_matrix(p.in[9] + (size_t)l * 4096 * 1024, 1024, 4096, 1024, 1024, wp + 4096 * 1024, ctr, tl, tid, bid, G);
  }
}

__device__ __forceinline__ void mod_phase(const Params& p, char* smem, int tid, int bid) {
  if (bid >= 192) return;
  float* sL = (float*)smem;
  float* red = sL + 9 * 1024;
  float* mod = (float*)(p.ws + OFF_MOD);
  for (int i = tid; i < 9 * 1024; i += NTHR) {
    float v = i < 8192 ? p.in[1][i] : p.in[3][i - 8192];
    sL[i] = v / (1.f + __expf(-v));
  }
  __syncthreads();
  for (int job = bid; job < 192; job += gridDim.x) {
    const int l = job / 48, cch = job % 48, cl = tid & 127, kg = tid >> 7;
    const float* W = p.in[6] + (size_t)l * 1024 * 6144 + cch * 128 + cl;
    float acc[9];
#pragma unroll
    for (int r = 0; r < 9; ++r) acc[r] = 0.f;
#pragma unroll 4
    for (int k = kg * 256; k < kg * 256 + 256; ++k) {
      const float w = W[(size_t)k * 6144];
#pragma unroll
      for (int r = 0; r < 9; ++r) acc[r] = fmaf(sL[r * 1024 + k], w, acc[r]);
    }
#pragma unroll
    for (int r = 0; r < 9; ++r) red[(kg * 9 + r) * 128 + cl] = acc[r];
    __syncthreads();
    for (int o = tid; o < 9 * 128; o += NTHR) {
      const int r = o >> 7, cc = o & 127;
      float s = red[(0 * 9 + r) * 128 + cc] + red[(1 * 9 + r) * 128 + cc] + red[(2 * 9 + r) * 128 + cc] + red[(3 * 9 + r) * 128 + cc];
      const float mv = s + p.in[7][(size_t)l * 6144 + cch * 128 + cc];
      mod[(size_t)(l * 9 + r) * 6144 + cch * 128 + cc] = mv;
      if ((cch >= 8 && cch < 16) || (cch >= 32 && cch < 40)) {
        const int which = cch >= 32 ? 1 : 0, c = (cch - (which ? 32 : 8)) * 128 + cc;
        const float g = (which ? p.in[5] : p.in[4])[(size_t)l * 1024 + c];
        ((float*)((char*)p.out + OUT_GAM))[(size_t)((l * 2 + which) * 9 + r) * 1024 + c] = g * (1.f + mv);
      }
    }
    __syncthreads();
  }
}


__device__ __forceinline__ void bias_phase(const Params& p, char* smem, int tid, int bid) {
  float* sL = (float*)smem;
  float* red = sL + 9 * 1024;
  const float* mod = (const float*)(p.ws + OFF_MOD);
  float* bias = (float*)((char*)p.out + OUT_BIAS);
  for (int job = bid; job < 206; job += gridDim.x) {
    int l, which, chunk, ncols, ld; const float* W;
    int q = job;
    if (q < 25) { l = 0; which = 0; chunk = q; } else if ((q -= 25) < 32) { l = 0; which = 1; chunk = q; }
    else if ((q -= 32) < 16) { l = 1; which = 0; chunk = q; } else if ((q -= 16) < 32) { l = 1; which = 1; chunk = q; }
    else if ((q -= 32) < 12) { l = 2; which = 0; chunk = q; } else if ((q -= 12) < 32) { l = 2; which = 1; chunk = q; }
    else if ((q -= 32) < 25) { l = 3; which = 0; chunk = q; } else { q -= 25; l = 3; which = 1; chunk = q; }
    if (which == 1) { ncols = 4096; ld = 4096; W = p.in[8] + (size_t)l * 1024 * 4096; }
    else if (l == 1) { ncols = 2048; ld = 2048; W = p.in[17]; }
    else if (l == 2) { ncols = 1536; ld = 1536; W = p.in[31]; }
    else { ncols = 3104; ld = 3104; W = p.in[10] + (size_t)(l / 3) * 1024 * 3104; }
    __syncthreads();
    for (int i = tid; i < 9 * 1024; i += NTHR) { const int r = i >> 10, k = i & 1023; sL[i] = mod[(size_t)(l * 9 + r) * 6144 + which * 3072 + k]; }
    __syncthreads();
    const int cl = tid & 127, kg = tid >> 7, col = chunk * 128 + cl;
    const bool valid = col < ncols;
    const float* Wc = W + (valid ? col : 0);
    float acc[9];
#pragma unroll
    for (int r = 0; r < 9; ++r) acc[r] = 0.f;
#pragma unroll 8
    for (int k = kg * 256; k < kg * 256 + 256; ++k) {
      const float w = Wc[(size_t)k * ld];
#pragma unroll
      for (int r = 0; r < 9; ++r) acc[r] = fmaf(sL[r * 1024 + k], w, acc[r]);
    }
#pragma unroll
    for (int r = 0; r < 9; ++r) red[(kg * 9 + r) * 128 + cl] = acc[r];
    __syncthreads();
    for (int o = tid; o < 9 * 128; o += NTHR) {
      const int r = o >> 7, cc = o & 127;
      const float sum = red[(0 * 9 + r) * 128 + cc] + red[(1 * 9 + r) * 128 + cc] + red[(2 * 9 + r) * 128 + cc] + red[(3 * 9 + r) * 128 + cc];
      if (chunk * 128 + cc < ncols) bias[(size_t)((l * 2 + which) * 9 + r) * 4096 + chunk * 128 + cc] = sum;
    }
  }
  __syncthreads();
}

__device__ __forceinline__ void norm_phase(const Params& p, int layer, int which, int Mrows, int tid, int bid) {
  const int lane = tid & 63, wid = tid >> 6;
  const float* mod = (const float*)(p.ws + OFF_MOD);
  const float* gsrc = (which == 0 ? p.in[4] : p.in[5]) + (size_t)layer * 1024;
  u16* H = (u16*)((char*)p.out + OUT_H);
  const bool first = (layer == 0 && which == 0);
  const int rstride = gridDim.x * 8;
  for (int row0 = bid * 8 + wid; row0 < Mrows; row0 += 2 * rstride) {
    float4 v[2][4];
#pragma unroll
    for (int q = 0; q < 2; ++q) {
      const int row = row0 + q * rstride;
      if (row < Mrows) {
        const float* xr = resid_row(p, first, row);
#pragma unroll
        for (int i = 0; i < 4; ++i) v[q][i] = ((const float4*)xr)[lane + 64 * i];
      }
    }
#pragma unroll
    for (int q = 0; q < 2; ++q) {
      const int row = row0 + q * rstride;
      if (row < Mrows) {
        float ss = 0.f;
#pragma unroll
        for (int i = 0; i < 4; ++i) ss += v[q][i].x * v[q][i].x + v[q][i].y * v[q][i].y + v[q][i].z * v[q][i].z + v[q][i].w * v[q][i].w;
        ss = wave_sum(ss);
        const float rstd = rsqrtf(ss * (1.f / 1024.f) + EPSN);
        const int midx = row < ML ? (row >> 12) : 8;
        const float* md = mod + (size_t)(layer * 9 + midx) * 6144 + which * 3072;
        float4 gv4[4], shv[4], scv[4];
#pragma unroll
        for (int i = 0; i < 4; ++i) { const int c = (lane + 64 * i) * 4; gv4[i] = *(const float4*)(gsrc + c); shv[i] = *(const float4*)(md + c); scv[i] = *(const float4*)(md + 1024 + c); }
#pragma unroll
        for (int i = 0; i < 4; ++i) {
          const int c = (lane + 64 * i) * 4;
          const float4 g = gv4[i], sh = shv[i], sc = scv[i];
          const float y0 = v[q][i].x * rstd * g.x * (1.f + sc.x) + sh.x, y1 = v[q][i].y * rstd * g.y * (1.f + sc.y) + sh.y;
          const float y2 = v[q][i].z * rstd * g.z * (1.f + sc.z) + sh.z, y3 = v[q][i].w * rstd * g.w * (1.f + sc.w) + sh.w;
          u32x2 w = {cvtpk(y0, y1), cvtpk(y2, y3)};
          *(u32x2*)(H + (size_t)row * 1024 + c) = w;
        }
      }
    }
  }
}

__device__ __forceinline__ void final_norm_phase(const Params& p, int tid, int bid) {
  const int lane = tid & 63, wid = tid >> 6;
  const u16* xs = (const u16*)(p.ws + OFF_XS);
  for (int row = bid * 8 + wid; row < ML; row += gridDim.x * 8) {
    const u16* xr = xs + (size_t)row * 1024;
    float v[16]; float ss = 0.f;
#pragma unroll
    for (int i = 0; i < 2; ++i) {
      const u32x4 w = *(const u32x4*)(xr + (lane + 64 * i) * 8);
#pragma unroll
      for (int q = 0; q < 4; ++q) { v[i * 8 + q * 2] = bflo(w[q]); v[i * 8 + q * 2 + 1] = bfhi(w[q]); }
    }
#pragma unroll
    for (int i = 0; i < 16; ++i) ss += v[i] * v[i];
    ss = wave_sum(ss);
    const float rstd = rsqrtf(ss * (1.f / 1024.f) + EPSN);
#pragma unroll
    for (int i = 0; i < 2; ++i) {
      const int c = (lane + 64 * i) * 8;
      const float4 g0 = *(const float4*)(p.in[35] + c), g1 = *(const float4*)(p.in[35] + c + 4);
      *(float4*)(p.out + (size_t)row * 1024 + c) = make_float4(v[i * 8 + 0] * rstd * g0.x, v[i * 8 + 1] * rstd * g0.y, v[i * 8 + 2] * rstd * g0.z, v[i * 8 + 3] * rstd * g0.w);
      *(float4*)(p.out + (size_t)row * 1024 + c + 4) = make_float4(v[i * 8 + 4] * rstd * g1.x, v[i * 8 + 5] * rstd * g1.y, v[i * 8 + 6] * rstd * g1.z, v[i * 8 + 7] * rstd * g1.w);
    }
  }
}

template <class Epi>
__device__ __forceinline__ void gemm_phase(const u16* __restrict__ A, int lda, const u16* __restrict__ Bt, int K, int Mrows, int N,
                                           const Epi& epi, char* smem, int tid, int bid) {
  const int lane = tid & 63, wid = tid >> 6, wm = wid >> 1, wn = wid & 1;
  const int fr = lane & 15, fq = lane >> 4;
  const int srow = tid >> 3, sch = tid & 7;
  const int nM = Mrows / 256, nN = N / 128, T = nM * nN, T8 = (T + 7) / 8;
  const int nk = K / 64;
  const int G = gridDim.x;
  for (int it = bid; it < T8 * 8; it += G) {
    const int v = (it & 7) * T8 + (it >> 3);
    if (v >= T) continue;
    const int m0 = (v / nN) * 256, n0 = (v % nN) * 128;
    f32x4 acc[4][4];
#pragma unroll
    for (int i = 0; i < 4; ++i)
#pragma unroll
      for (int j = 0; j < 4; ++j) acc[i][j] = f32x4{0.f, 0.f, 0.f, 0.f};
    const u16* Ag = A + (size_t)(m0 + srow) * lda + sch * 8;
    const u16* Bg = Bt + (size_t)(n0 + srow) * K + sch * 8;
    bf16x8 ra[4], rb[2];
#pragma unroll
    for (int i = 0; i < 4; ++i) ra[i] = *(const bf16x8*)(Ag + (size_t)i * 64 * lda);
#pragma unroll
    for (int i = 0; i < 2; ++i) rb[i] = *(const bf16x8*)(Bg + (size_t)i * 64 * K);
    const int woff = swz128(srow, sch);
    __syncthreads();
#pragma unroll
    for (int i = 0; i < 4; ++i) *(bf16x8*)(smem + woff + i * 8192) = ra[i];
#pragma unroll
    for (int i = 0; i < 2; ++i) *(bf16x8*)(smem + 65536 + woff + i * 8192) = rb[i];
    __syncthreads();
    for (int kt = 0; kt < nk; ++kt) {
      const int s = kt & 1;
      if (kt + 1 < nk) {
#pragma unroll
        for (int i = 0; i < 4; ++i) ra[i] = *(const bf16x8*)(Ag + (size_t)i * 64 * lda + (kt + 1) * 64);
#pragma unroll
        for (int i = 0; i < 2; ++i) rb[i] = *(const bf16x8*)(Bg + (size_t)i * 64 * K + (kt + 1) * 64);
      }
      const char* sA = smem + s * 32768;
      const char* sB = smem + 65536 + s * 16384;
#pragma unroll
      for (int kk = 0; kk < 2; ++kk) {
        const int ch = kk * 4 + fq;
        bf16x8 af[4], bfr[4];
#pragma unroll
        for (int i = 0; i < 4; ++i) af[i] = *(const bf16x8*)(sA + swz128(wm * 64 + i * 16 + fr, ch));
#pragma unroll
        for (int i = 0; i < 4; ++i) bfr[i] = *(const bf16x8*)(sB + swz128(wn * 64 + i * 16 + fr, ch));
#pragma unroll
        for (int i = 0; i < 4; ++i)
#pragma unroll
          for (int j = 0; j < 4; ++j) acc[i][j] = __builtin_amdgcn_mfma_f32_16x16x32_bf16(bfr[j], af[i], acc[i][j], 0, 0, 0);
      }
      if (kt + 1 < nk) {
        char* dA = smem + (s ^ 1) * 32768;
        char* dB = smem + 65536 + (s ^ 1) * 16384;
#pragma unroll
        for (int i = 0; i < 4; ++i) *(bf16x8*)(dA + woff + i * 8192) = ra[i];
#pragma unroll
        for (int i = 0; i < 2; ++i) *(bf16x8*)(dB + woff + i * 8192) = rb[i];
      }
      __syncthreads();
    }
#pragma unroll
    for (int i = 0; i < 4; ++i)
#pragma unroll
      for (int j = 0; j < 4; ++j) epi(m0 + wm * 64 + i * 16 + fr, n0 + wn * 64 + j * 16 + fq * 4, acc[i][j]);
  }
}

struct EpiStore {
  u16* dst; int ld; int nvalid;
  __device__ __forceinline__ void operator()(int m, int n, f32x4 v) const {
    if (n < nvalid) { u32x2 w = {cvtpk(v[0], v[1]), cvtpk(v[2], v[3])}; *(u32x2*)(dst + (size_t)m * ld + n) = w; }
  }
};
struct EpiSqRelu {
  u16* dst; int ld;
  __device__ __forceinline__ void operator()(int m, int n, f32x4 v) const {
    float a = fmaxf(v[0], 0.f), b = fmaxf(v[1], 0.f), c = fmaxf(v[2], 0.f), d = fmaxf(v[3], 0.f);
    u32x2 w = {cvtpk(a * a, b * b), cvtpk(c * c, d * d)}; *(u32x2*)(dst + (size_t)m * ld + n) = w;
  }
};
struct EpiResid {
  const Params* p; bool first; const float* gl;
  __device__ __forceinline__ void operator()(int m, int n, f32x4 v) const {
    const int midx = m < ML ? (m >> 12) : 8;
    const float4 g = *(const float4*)(gl + (size_t)midx * 6144 + n);
    const float4 r = *(const float4*)(resid_row(*p, first, m) + n);
    float4 o = make_float4(r.x + g.x * v[0], r.y + g.y * v[1], r.z + g.z * v[2], r.w + g.w * v[3]);
    *(float4*)((float*)(p->ws + OFF_XS) + (size_t)m * 1024 + n) = o;
  }
};


#define PG8_LAS __attribute__((address_space(3)))
constexpr int PG_BM = 256, PG_BK = 64, PG_HALF = 128, PG_HTB = PG_HALF * PG_BK * 2;
__device__ __forceinline__ int lds_byte(int r, int c) { const int st = (r >> 4) * 2 + (c >> 5), rr = r & 15, cc = c & 31, ob = rr * 64 + cc * 2; return st * 1024 + (ob ^ (((ob >> 9) & 1) << 5)); }
__device__ __forceinline__ void stage_rc(int b, int& R, int& C) { const int st = b / 1024, sb = b % 1024, swz = sb ^ (((sb >> 9) & 1) << 5); R = (st >> 1) * 16 + swz / 64; C = (st & 1) * 32 + (swz % 64) / 2; }
__device__ __forceinline__ int perm32(int rho) { const int n = rho >> 4, i = rho & 15; return 8 * (i >> 2) + 4 * n + (i & 3); }
struct Unit { int pm, pn; };
struct StaticOrder {
  int nM, nN, nwg, G, c;
  __device__ __forceinline__ void init(int M, int N, int G_, int c_) { nM = M / PG_BM; nN = N / PG_BM; nwg = nM * nN; G = G_; c = c_; }
  __device__ __forceinline__ bool next(int i, Unit& u) const {
    const long L = (long)i * G + c; if (L >= nwg) return false;
    int wgid = (int)L; { const int q = nwg / 8, r = nwg % 8, xcd = wgid % 8, off = wgid / 8; wgid = (xcd < r ? xcd * (q + 1) : r * (q + 1) + (xcd - r) * q) + off; }
    const int nig = 8 * nN, gid = wgid / nig, fm = gid * 8, gsz = (nM - fm) < 8 ? (nM - fm) : 8;
    u.pm = fm + ((wgid % nig) % gsz); u.pn = (wgid % nig) / gsz; return true;
  }
};
struct EpiStoreP {
  static constexpr bool PERM = true;
  u16* O; int ldc; int nvalid; int act; const float* ssq; const float* bias;
  __device__ __forceinline__ void operator()(const f32x4 (&acc)[2][2][4][2], const Unit& u, int wr, int wc, int fr, int fq) const {
    const int row0 = u.pm * PG_BM + wr * 64 + fr, col0 = u.pn * PG_BM + wc * 32 + 8 * fq;
    const int midx = (u.pm * PG_BM < ML) ? ((u.pm * PG_BM) >> 12) : 8;
    f32x4 bv[2][2];
#pragma unroll
    for (int bj = 0; bj < 2; ++bj)
#pragma unroll
      for (int n = 0; n < 2; ++n) bv[bj][n] = ssq ? *(const f32x4*)(bias + (size_t)midx * 4096 + col0 + bj * PG_HALF + 4 * n) : f32x4{0.f, 0.f, 0.f, 0.f};
    float rs[8];
    if (ssq) {
      const int lane = fr + 16 * fq;
      f32x4 sv[8];
#pragma unroll
      for (int k = 0; k < 8; ++k) sv[k] = *(const f32x4*)(ssq + (size_t)(row0 + (k >> 2) * PG_HALF + (k & 3) * 16) * 16 + fq * 4);
#pragma unroll
      for (int k = 0; k < 8; ++k) {
        float t = (sv[k][0] + sv[k][1]) + (sv[k][2] + sv[k][3]);
        t += __int_as_float(__builtin_amdgcn_ds_bpermute((lane ^ 16) << 2, __float_as_int(t)));
        t += __int_as_float(__builtin_amdgcn_ds_bpermute((lane ^ 32) << 2, __float_as_int(t)));
        rs[k] = rsqrtf(t * (1.f / 1024.f) + EPSN);
      }
    } else {
#pragma unroll
      for (int k = 0; k < 8; ++k) rs[k] = 1.f;
    }
#pragma unroll
    for (int ai = 0; ai < 2; ++ai)
#pragma unroll
      for (int m = 0; m < 4; ++m) {
        const int row = row0 + ai * PG_HALF + m * 16;
        const float rstd = rs[ai * 4 + m];
        u16* rowp = O + (size_t)row * ldc + col0;
#pragma unroll
        for (int bj = 0; bj < 2; ++bj) { f32x4 v0 = acc[ai][bj][m][0] * rstd + bv[bj][0], v1 = acc[ai][bj][m][1] * rstd + bv[bj][1];
          if (act == 1) {
#pragma unroll
            for (int q = 0; q < 4; ++q) { const float a = fmaxf(v0[q], 0.f), b = fmaxf(v1[q], 0.f); v0[q] = a * a; v1[q] = b * b; } }
          u32x4 w = {cvtpk(v0[0], v0[1]), cvtpk(v0[2], v0[3]), cvtpk(v1[0], v1[1]), cvtpk(v1[2], v1[3])};
          if (col0 + bj * PG_HALF < nvalid) *(u32x4*)(rowp + bj * PG_HALF) = w; } }
  }
};
struct EpiResidP {
  static constexpr bool PERM = true;
  const Params* p; bool first; const float* gl; bool emit; const float* gam; u16* Hout; float* ssq;
  __device__ __forceinline__ void operator()(const f32x4 (&acc)[2][2][4][2], const Unit& u, int wr, int wc, int fr, int fq) const {
    const int row0 = u.pm * PG_BM + wr * 64 + fr, col0 = u.pn * PG_BM + wc * 32 + 8 * fq;
    const int midx = (u.pm * PG_BM < ML) ? ((u.pm * PG_BM) >> 12) : 8;
    const float* gp = gl + (size_t)midx * 6144 + col0;
    const float* gmp = gam + (size_t)midx * 1024 + col0;
    const int lane = fr + 16 * fq;
    float4 gq[2][2], gmq[2][2];
#pragma unroll
    for (int bj = 0; bj < 2; ++bj)
#pragma unroll
      for (int n = 0; n < 2; ++n) {
        gq[bj][n] = *(const float4*)(gp + bj * PG_HALF + n * 4);
        gmq[bj][n] = emit ? *(const float4*)(gmp + bj * PG_HALF + n * 4) : make_float4(0.f, 0.f, 0.f, 0.f);
      }
    u32x4 rwq[4][2][2];
    if (!first) {
#pragma unroll
      for (int m = 0; m < 2; ++m) {
        const u16* op = (const u16*)(p->ws + OFF_XS) + (size_t)(row0 + m * 16) * 1024 + col0;
#pragma unroll
        for (int bj = 0; bj < 2; ++bj) rwq[0][m][bj] = *(const u32x4*)(op + bj * PG_HALF);
      }
    }
#pragma unroll
    for (int aim = 0; aim < 4; ++aim) {
      const int ai = aim >> 1, mb = (aim & 1) * 2;
      if (!first && aim < 3) {
        const int ai2 = (aim + 1) >> 1, mb2 = ((aim + 1) & 1) * 2;
#pragma unroll
        for (int m = 0; m < 2; ++m) {
          const u16* op = (const u16*)(p->ws + OFF_XS) + (size_t)(row0 + ai2 * PG_HALF + (mb2 + m) * 16) * 1024 + col0;
#pragma unroll
          for (int bj = 0; bj < 2; ++bj) rwq[aim + 1][m][bj] = *(const u32x4*)(op + bj * PG_HALF);
        }
      }
#pragma unroll
      for (int m = mb; m < mb + 2; ++m) {
        const int row = row0 + ai * PG_HALF + m * 16;
        u16* op = (u16*)(p->ws + OFF_XS) + (size_t)row * 1024 + col0;
        u16* hp = Hout + (size_t)row * 1024 + col0;
        float sq = 0.f;
#pragma unroll
        for (int bj = 0; bj < 2; ++bj) {
          float x[8], rr[8];
          if (first) {
            const float* rp = resid_row(*p, true, row) + col0;
            const float4 r0 = *(const float4*)(rp + bj * PG_HALF), r1 = *(const float4*)(rp + bj * PG_HALF + 4);
            rr[0] = r0.x; rr[1] = r0.y; rr[2] = r0.z; rr[3] = r0.w; rr[4] = r1.x; rr[5] = r1.y; rr[6] = r1.z; rr[7] = r1.w;
          } else {
            const u32x4 rw = rwq[aim][m - mb][bj];
#pragma unroll
            for (int q = 0; q < 4; ++q) { rr[q * 2] = bflo(rw[q]); rr[q * 2 + 1] = bfhi(rw[q]); }
          }
#pragma unroll
          for (int n = 0; n < 2; ++n) {
            const float4 g = gq[bj][n];
            const f32x4 a = acc[ai][bj][m][n];
            x[n * 4 + 0] = rr[n * 4 + 0] + g.x * a[0]; x[n * 4 + 1] = rr[n * 4 + 1] + g.y * a[1]; x[n * 4 + 2] = rr[n * 4 + 2] + g.z * a[2]; x[n * 4 + 3] = rr[n * 4 + 3] + g.w * a[3];
          }
          { u32x4 xw = {cvtpk(x[0], x[1]), cvtpk(x[2], x[3]), cvtpk(x[4], x[5]), cvtpk(x[6], x[7])}; *(u32x4*)(op + bj * PG_HALF) = xw; }
          if (emit) {
            const float4 g0 = gmq[bj][0], g1 = gmq[bj][1];
            sq += ((x[0] * x[0] + x[1] * x[1]) + (x[2] * x[2] + x[3] * x[3])) + ((x[4] * x[4] + x[5] * x[5]) + (x[6] * x[6] + x[7] * x[7]));
            u32x4 w = {cvtpk(x[0] * g0.x, x[1] * g0.y), cvtpk(x[2] * g0.z, x[3] * g0.w), cvtpk(x[4] * g1.x, x[5] * g1.y), cvtpk(x[6] * g1.z, x[7] * g1.w)};
            *(u32x4*)(hp + bj * PG_HALF) = w;
          }
        }
        if (emit) {
          sq += __int_as_float(__builtin_amdgcn_ds_bpermute((lane ^ 16) << 2, __float_as_int(sq)));
          sq += __int_as_float(__builtin_amdgcn_ds_bpermute((lane ^ 32) << 2, __float_as_int(sq)));
          if (fq == 0) ssq[(size_t)row * 16 + u.pn * 4 + wc] = sq;
        }
      }
    }
  }
};
template <class Epi>
__device__ __forceinline__ void gemm8_phase(char* smem, const u16* gA, const u16* gBt, int M, int N, int K, const Epi& E, int tid, int bid, int ldk = 0, int nks = 1) {
  PG8_LAS unsigned char* lds = (PG8_LAS unsigned char*)smem;
  if (ldk == 0) ldk = K;
  const int nNr = N / PG_BM;
  StaticOrder S; S.init(M, N * nks, gridDim.x, bid);
  const int wid = __builtin_amdgcn_readfirstlane(tid >> 6), lane = tid & 63, wr = wid >> 2, wc = wid & 3, fr = lane & 15, fq = lane >> 4;
  const int nt = K / PG_BK;
  unsigned voffA[2], voffB[2];
#pragma unroll
  for (int i = 0; i < 2; ++i) { int R, C; stage_rc(tid * 16 + i * 8192, R, C); const int Rb = Epi::PERM ? ((R & ~31) + perm32(R & 31)) : R;
    voffA[i] = (unsigned)(R * ldk + C) * 2u; voffB[i] = (unsigned)(Rb * ldk + C) * 2u; }
  const size_t kstep = (size_t)(PG_BK * 2);
  const size_t hstep = (size_t)PG_HALF * ldk * 2;
  const size_t ksb = (size_t)K * 2;
  const size_t tstep = 2 * hstep;
  const unsigned ldsw = (unsigned)wid * 1024u;
  const int aoff = lds_byte(wr * 64 + fr, fq * 8), boff = lds_byte(wc * 32 + fr, fq * 8);
#define PG8_SA(b, h) (((b) * 2 + (h)) * PG_HTB)
#define PG8_SB(b, h) ((4 + (b) * 2 + (h)) * PG_HTB)
#define PG8_STAGE(bufoff, gbase, voff) do { _Pragma("unroll") for (int _i = 0; _i < 2; ++_i) \
    __builtin_amdgcn_global_load_lds((const unsigned*)((const char*)(gbase) + (voff)[_i]), (PG8_LAS unsigned*)(lds + (bufoff) + ldsw + _i * 8192), 16, 0, 0); } while (0)
#define PG8_LDA(dst, b, h) do { _Pragma("unroll") for (int m = 0; m < 4; ++m) _Pragma("unroll") for (int k = 0; k < 2; ++k) dst[m][k] = *(const PG8_LAS bf16x8*)(lds + PG8_SA(b, h) + aoff + m * 2048 + k * 1024); } while (0)
#define PG8_LDB(dst, b, h) do { _Pragma("unroll") for (int n = 0; n < 2; ++n) _Pragma("unroll") for (int k = 0; k < 2; ++k) dst[n][k] = *(const PG8_LAS bf16x8*)(lds + PG8_SB(b, h) + boff + n * 2048 + k * 1024); } while (0)
#define PG8_MMA(ai, bj, At, Bt) do { __builtin_amdgcn_s_setprio(1); _Pragma("unroll") for (int m = 0; m < 4; ++m) _Pragma("unroll") for (int n = 0; n < 2; ++n) _Pragma("unroll") for (int k = 0; k < 2; ++k) \
    acc[ai][bj][m][n] = __builtin_amdgcn_mfma_f32_16x16x32_bf16(Bt[n][k], At[m][k], acc[ai][bj][m][n], 0, 0, 0); __builtin_amdgcn_s_setprio(0); } while (0)
#define PG8_WAIT_V(n) asm volatile("s_waitcnt vmcnt(" #n ")" ::: "memory")
#define PG8_WAIT_L(n) asm volatile("s_waitcnt lgkmcnt(" #n ")" ::: "memory")
#define PG8_BAR __builtin_amdgcn_s_barrier()
#define PG8_SCHED __builtin_amdgcn_sched_barrier(0)
  Unit cur, nxt; int ui = 0;
  if (!S.next(0, cur)) return;
  f32x4 acc[2][2][4][2];
#pragma unroll
  for (int a = 0; a < 2; ++a)
#pragma unroll
    for (int b = 0; b < 2; ++b)
#pragma unroll
      for (int m = 0; m < 4; ++m)
#pragma unroll
        for (int n = 0; n < 2; ++n) acc[a][b][m][n] = (f32x4){0.f, 0.f, 0.f, 0.f};
  bf16x8 At[4][2], B0[2][2], B1[2][2];
  const char* cA = (const char*)gA + (size_t)cur.pm * tstep + (size_t)(cur.pn / nNr) * ksb; const char* cB = (const char*)gBt + (size_t)(cur.pn % nNr) * tstep + (size_t)(cur.pn / nNr) * ksb;
  PG8_STAGE(PG8_SB(0, 0), cB, voffB); PG8_STAGE(PG8_SA(0, 0), cA, voffA); PG8_STAGE(PG8_SB(0, 1), cB + hstep, voffB); PG8_STAGE(PG8_SA(0, 1), cA + hstep, voffA);
  if (wr == 1) PG8_BAR;
  PG8_WAIT_V(4); PG8_BAR;
  PG8_STAGE(PG8_SB(1, 0), cB + kstep, voffB); PG8_STAGE(PG8_SA(1, 0), cA + kstep, voffA); PG8_STAGE(PG8_SB(1, 1), cB + hstep + kstep, voffB);
  PG8_WAIT_V(6); PG8_BAR;
  for (;;) {
    const bool has_next = S.next(ui + 1, nxt);
    const char* nA = has_next ? (const char*)gA + (size_t)nxt.pm * tstep + (size_t)(nxt.pn / nNr) * ksb : cA; const char* nB = has_next ? (const char*)gBt + (size_t)(nxt.pn % nNr) * tstep + (size_t)(nxt.pn / nNr) * ksb : cB;
    for (int t = 0; t < nt; t += 2) {
      const bool last = (t == nt - 2);
      const char* a1 = cA + (size_t)(t + 1) * kstep;
      const char* a2 = last ? nA : cA + (size_t)(t + 2) * kstep; const char* b2 = last ? nB : cB + (size_t)(t + 2) * kstep;
      const char* a3 = a2 + kstep; const char* b3 = b2 + kstep;
      PG8_LDB(B0, 0, 0); PG8_SCHED; PG8_LDA(At, 0, 0); PG8_STAGE(PG8_SA(1, 1), a1 + hstep, voffA);
      PG8_WAIT_L(8); PG8_BAR; PG8_WAIT_L(0); PG8_MMA(0, 0, At, B0); PG8_BAR; PG8_SCHED;
      PG8_LDB(B1, 0, 1); PG8_STAGE(PG8_SB(0, 0), b2, voffB);
      PG8_BAR; PG8_WAIT_L(0); PG8_MMA(0, 1, At, B1); PG8_BAR;
      PG8_LDA(At, 0, 1); PG8_STAGE(PG8_SA(0, 0), a2, voffA);
      PG8_BAR; PG8_WAIT_L(0); PG8_MMA(1, 0, At, B0); PG8_BAR; PG8_SCHED;
      PG8_STAGE(PG8_SB(0, 1), b2 + hstep, voffB);
      PG8_WAIT_V(6); PG8_BAR; PG8_MMA(1, 1, At, B1); PG8_BAR;
      PG8_LDB(B0, 1, 0); PG8_SCHED; PG8_LDA(At, 1, 0); PG8_STAGE(PG8_SA(0, 1), a2 + hstep, voffA);
      PG8_WAIT_L(8); PG8_BAR; PG8_WAIT_L(0); PG8_MMA(0, 0, At, B0); PG8_BAR; PG8_SCHED;
      PG8_LDB(B1, 1, 1); PG8_STAGE(PG8_SB(1, 0), b3, voffB);
      PG8_BAR; PG8_WAIT_L(0); PG8_MMA(0, 1, At, B1); PG8_BAR;
      PG8_LDA(At, 1, 1); PG8_STAGE(PG8_SA(1, 0), a3, voffA);
      PG8_BAR; PG8_WAIT_L(0); PG8_MMA(1, 0, At, B0); PG8_BAR; PG8_SCHED;
      PG8_STAGE(PG8_SB(1, 1), b3 + hstep, voffB);
      PG8_WAIT_V(6); PG8_BAR; PG8_MMA(1, 1, At, B1); PG8_BAR;
    }
    E(acc, cur, wr, wc, fr, fq);
    if (!has_next) break;
#pragma unroll
    for (int a = 0; a < 2; ++a)
#pragma unroll
      for (int b = 0; b < 2; ++b)
#pragma unroll
        for (int m = 0; m < 4; ++m)
#pragma unroll
          for (int n = 0; n < 2; ++n) acc[a][b][m][n] = (f32x4){0.f, 0.f, 0.f, 0.f};
    cur = nxt; cA = nA; cB = nB; ++ui;
  }
  PG8_WAIT_V(0);
  if (wr == 0) PG8_BAR;
  PG8_BAR;
#undef PG8_SA
#undef PG8_SB
#undef PG8_STAGE
#undef PG8_LDA
#undef PG8_LDB
#undef PG8_MMA
#undef PG8_WAIT_V
#undef PG8_WAIT_L
#undef PG8_BAR
#undef PG8_SCHED
}


constexpr size_t OFF_PART = OFF_S + (size_t)300000000;
struct EpiPart {
  static constexpr bool PERM = true;
  float* part;
  __device__ __forceinline__ void operator()(const f32x4 (&acc)[2][2][4][2], const Unit& u, int wr, int wc, int fr, int fq) const {
    const int ks = u.pn >> 2, pn = u.pn & 3;
    const int row0 = u.pm * PG_BM + wr * 64 + fr, col0 = pn * PG_BM + wc * 32 + 8 * fq;
#pragma unroll
    for (int ai = 0; ai < 2; ++ai)
#pragma unroll
      for (int m = 0; m < 4; ++m) {
        float* op = part + ((size_t)ks * MC + row0 + ai * PG_HALF + m * 16) * 1024 + col0;
#pragma unroll
        for (int bj = 0; bj < 2; ++bj)
#pragma unroll
          for (int n = 0; n < 2; ++n) *(f32x4*)(op + bj * PG_HALF + n * 4) = acc[ai][bj][m][n];
      }
  }
};
__device__ __forceinline__ void ctx_fix_phase(const Params& p, bool first, const float* gl8, const float* gam8, int nks, int tid, int bid) {
  const int lane = tid & 63, wid = tid >> 6;
  const float* part = (const float*)(p.ws + OFF_PART);
  u16* H = (u16*)((char*)p.out + OUT_H);
  float* ssq = (float*)((char*)p.out + OUT_SSQ);
  for (int r = bid * 8 + wid; r < MC; r += gridDim.x * 8) {
    const int row = ML + r;
    const float* rp = resid_row(p, true, row);
    u16* xo = (u16*)(p.ws + OFF_XS) + (size_t)row * 1024;
    float sq = 0.f;
    float4 av[4], rv[4], gv4[4], gmv[4];
#pragma unroll
    for (int i = 0; i < 4; ++i) {
      const int c = (lane + 64 * i) * 4;
      const float4 z = make_float4(0.f, 0.f, 0.f, 0.f);
      const float4 a0 = *(const float4*)(part + (size_t)r * 1024 + c);
      const float4 a1 = *(const float4*)(part + ((size_t)1 * MC + r) * 1024 + c);
      const float4 a2 = nks > 2 ? *(const float4*)(part + ((size_t)2 * MC + r) * 1024 + c) : z;
      const float4 a3 = nks > 2 ? *(const float4*)(part + ((size_t)3 * MC + r) * 1024 + c) : z;
      av[i] = make_float4((a0.x + a1.x) + (a2.x + a3.x), (a0.y + a1.y) + (a2.y + a3.y), (a0.z + a1.z) + (a2.z + a3.z), (a0.w + a1.w) + (a2.w + a3.w));
      gv4[i] = *(const float4*)(gl8 + c); gmv[i] = *(const float4*)(gam8 + c);
      if (first) rv[i] = *(const float4*)(rp + c);
      else { const u32x2 rw = *(const u32x2*)(xo + c); rv[i] = make_float4(bflo(rw[0]), bfhi(rw[0]), bflo(rw[1]), bfhi(rw[1])); }
    }
#pragma unroll
    for (int i = 0; i < 4; ++i) {
      const int c = (lane + 64 * i) * 4;
      const float4 a = av[i], rr = rv[i], g = gv4[i], gm = gmv[i];
      const float x0 = rr.x + g.x * a.x, x1 = rr.y + g.y * a.y, x2 = rr.z + g.z * a.z, x3 = rr.w + g.w * a.w;
      { u32x2 xw = {cvtpk(x0, x1), cvtpk(x2, x3)}; *(u32x2*)(xo + c) = xw; }
      sq += (x0 * x0 + x1 * x1) + (x2 * x2 + x3 * x3);
      u32x2 w = {cvtpk(x0 * gm.x, x1 * gm.y), cvtpk(x2 * gm.z, x3 * gm.w)};
      *(u32x2*)(H + (size_t)row * 1024 + c) = w;
    }
    sq = wave_sum(sq);
    if (lane < 16) ssq[(size_t)row * 16 + lane] = lane == 0 ? sq : 0.f;
  }
}


constexpr size_t OFF_GQB = OFF_S + (size_t)300000000;
__device__ __forceinline__ void gla_pre_phase(const Params& p, int j, char* smem, int tid, int bid) {
  float* segtot = (float*)smem;
  u16* P = (u16*)(p.ws + OFF_S);
  u16* QB = (u16*)(p.ws + OFF_GQB);
  u16* KB2 = (u16*)((char*)p.out + OUT_GKB);
  float* EBE = (float*)((char*)p.out + OUT_EBE);
  const float QSCALE = 0.08838834764831845f;
  bf16x8 wf_f, wf_b; float bias_f = 0.f, bias_b = 0.f; int h_loaded = -1;
  unsigned nqv[16], nkv[16]; bf16x8 ngqf, ngqb;
#define GPRE_LOAD(job_) do { const int h2 = (job_) & 3, rb2 = ((job_) >> 2) * 64; \
    const u16* grow = P + (size_t)(rb2 + (wid >> 2) * 32 + l32) * LDP + 3072 + hi * 8; \
    ngqf = *(const bf16x8*)(grow); ngqb = *(const bf16x8*)(grow + 16); \
    const u16* pq2 = P + (size_t)(rb2 + (wid >> 2) * 32 + 4 * hi) * LDP + h2 * 128 + (wid & 3) * 32 + l32; \
    _Pragma("unroll") for (int i = 0; i < 16; ++i) { const u16* pr = pq2 + (size_t)((i & 3) + 8 * (i >> 2)) * LDP; nqv[i] = pr[0]; nkv[i] = pr[512]; } } while (0)
  { const int lane = tid & 63, wid = tid >> 6, l32 = lane & 31, hi = lane >> 5; if (bid < 544 * 4) GPRE_LOAD(bid); }
  for (int job = bid; job < 544 * 4; job += gridDim.x) {
    asm volatile("" : "+v"(tid));
    const int lane = tid & 63, wid = tid >> 6, l32 = lane & 31, hi = lane >> 5;
    const int tbg = wid >> 2, kd = (wid & 3) * 32 + l32;
    const int h = job & 3, blk = job >> 2, rowb = blk * 64;
    if (h != h_loaded) {
      const float* wuf = p.in[11] + (size_t)j * 16 * 512 + h * 128 + kd;
      const float* wub = p.in[13] + (size_t)j * 16 * 512 + h * 128 + kd;
      float a[8], c[8];
#pragma unroll
      for (int jj = 0; jj < 8; ++jj) { a[jj] = wuf[(hi * 8 + jj) * 512]; c[jj] = wub[(hi * 8 + jj) * 512]; }
      u32x4 pa = {cvtpk(a[0], a[1]), cvtpk(a[2], a[3]), cvtpk(a[4], a[5]), cvtpk(a[6], a[7])};
      u32x4 pc = {cvtpk(c[0], c[1]), cvtpk(c[2], c[3]), cvtpk(c[4], c[5]), cvtpk(c[6], c[7])};
      wf_f = *reinterpret_cast<bf16x8*>(&pa); wf_b = *reinterpret_cast<bf16x8*>(&pc);
      bias_f = p.in[12][(size_t)j * 512 + h * 128 + kd]; bias_b = p.in[14][(size_t)j * 512 + h * 128 + kd];
      h_loaded = h;
    }
    const bf16x8 gqf = ngqf, gqb = ngqb;
    unsigned qv[16], kv[16];
#pragma unroll
    for (int i = 0; i < 16; ++i) { qv[i] = nqv[i]; kv[i] = nkv[i]; }
    u16* pq = P + (size_t)(rowb + tbg * 32 + 4 * hi) * LDP + h * 128 + kd;
    __builtin_amdgcn_sched_barrier(0);
    if (job + (int)gridDim.x < 544 * 4) GPRE_LOAD(job + (int)gridDim.x);
    __builtin_amdgcn_sched_barrier(0);
    float pf[16], pb[16], lsb[16]; float totf, totb;
    {
      f32x16 xf, xb;
#pragma unroll
      for (int r = 0; r < 16; ++r) { xf[r] = 0.f; xb[r] = 0.f; }
      xf = __builtin_amdgcn_mfma_f32_32x32x16_bf16(gqf, wf_f, xf, 0, 0, 0);
      xb = __builtin_amdgcn_mfma_f32_32x32x16_bf16(gqb, wf_b, xb, 0, 0, 0);
      float t4f[4], t4b[4];
#pragma unroll
      for (int g = 0; g < 4; ++g) {
        float cf = 0.f, cb = 0.f;
#pragma unroll
        for (int i = 0; i < 4; ++i) {
          const float x1 = xf[g * 4 + i] + bias_f, x2 = xb[g * 4 + i] + bias_b;
          const float l1 = (fminf(x1, 0.f) - flog(1.f + fexp(-fabsf(x1)))) * (1.f / 16.f);
          const float l2 = (fminf(x2, 0.f) - flog(1.f + fexp(-fabsf(x2)))) * (1.f / 16.f);
          cf += l1; cb += l2; pf[g * 4 + i] = cf; pb[g * 4 + i] = cb; lsb[g * 4 + i] = l2;
        }
        t4f[g] = cf; t4b[g] = cb;
      }
      float runf = 0.f, runb = 0.f;
#pragma unroll
      for (int g = 0; g < 4; ++g) {
        auto r1 = __builtin_amdgcn_permlane32_swap(__float_as_uint(t4f[g]), __float_as_uint(t4f[g]), false, false);
        auto r2 = __builtin_amdgcn_permlane32_swap(__float_as_uint(t4b[g]), __float_as_uint(t4b[g]), false, false);
        const float f0 = __uint_as_float(r1[0]), f1 = __uint_as_float(r1[1]), b0 = __uint_as_float(r2[0]), b1 = __uint_as_float(r2[1]);
        const float of = hi ? runf + f0 : runf, ob = hi ? runb + b0 : runb;
#pragma unroll
        for (int i = 0; i < 4; ++i) { pf[g * 4 + i] += of; pb[g * 4 + i] += ob; }
        runf += f0 + f1; runb += b0 + b1;
      }
      totf = runf; totb = runb;
    }
    if (hi == 0) { segtot[(0 * 2 + tbg) * 128 + kd] = totf; segtot[(1 * 2 + tbg) * 128 + kd] = totb; }
    __syncthreads();
    {
      const float f0 = segtot[kd], f1 = segtot[128 + kd], b0 = segtot[256 + kd], b1 = segtot[384 + kd];
      const float offf = tbg ? f0 : 0.f, offb = tbg ? b0 : 0.f;
      const float bendf = f0 + f1, bendb = b0 + b1;
      if (tbg == 0 && hi == 0) {
        EBE[(size_t)(0 * 544 + blk) * 512 + h * 128 + kd] = fexp(bendf);
        EBE[(size_t)(1 * 544 + blk) * 512 + h * 128 + kd] = fexp(bendb);
      }
      u16* pqb = QB + (size_t)(rowb + tbg * 32 + 4 * hi) * 512 + h * 128 + kd;
      u16* pkb = KB2 + (size_t)(rowb + tbg * 32 + 4 * hi) * 512 + h * 128 + kd;
#pragma unroll
      for (int i = 0; i < 16; ++i) {
        const float qf = __uint_as_float(qv[i] << 16), kf = __uint_as_float(kv[i] << 16);
        const size_t ro = (size_t)((i & 3) + 8 * (i >> 2));
        const float bf_ = pf[i] + offf;
        const float bb_ = bendb - (pb[i] + offb) + lsb[i];
        const float e1 = fexp(-bf_), e2 = fexp(-bb_);
        pq[ro * LDP] = f2bf(qf * (__builtin_amdgcn_rcpf(e1) * QSCALE));
        pq[ro * LDP + 512] = f2bf(kf * e1);
        pqb[ro * 512] = f2bf(qf * (__builtin_amdgcn_rcpf(e2) * QSCALE));
        pkb[ro * 512] = f2bf(kf * e2);
      }
    }
    __syncthreads();
  }
#undef GPRE_LOAD
}

__device__ __forceinline__ void gla_scan_phase(const Params& p, int j, bool need_ctx, char* smem, int tid, int bid) {
  const int lane = tid & 63, wid = tid >> 6, l32 = lane & 31, hi = lane >> 5;
  char* qbL = smem;
  char* kinvL = smem + 16384;
  char* kendT = smem + 32768;
  char* vT0 = smem + 49152;
  char* scL = smem + 57344;
  char* STL = smem + 65536;
  float* ebend = (float*)(smem + 81920);
  float* segtot = (float*)(smem + 82432);
  float* g16L = (float*)(smem + 84480);
  const u16* P = (const u16*)(p.ws + OFF_S);
  u16* OF = (u16*)((char*)p.out + OUT_H);
  u16* OB = (u16*)(p.ws + OFF_S + (size_t)MT * LDP * 2);
  const float QSCALE = 0.08838834764831845f;
  for (int unit = bid; unit < 256; unit += gridDim.x) {
    const int dir = unit & 1, dvs = (unit >> 1) & 3, h = (unit >> 3) & 3, b = unit >> 5;
    const int dvc = tid & 63, tg = tid >> 6;
    f32x16 Sacc;
#pragma unroll
    for (int r = 0; r < 16; ++r) Sacc[r] = 0.f;
    __syncthreads();
    { u32x4 z = {0u, 0u, 0u, 0u}; *(u32x4*)(STL + tid * 32) = z; *(u32x4*)(STL + tid * 32 + 16) = z; }
    u32x4 qx[2], kx[2]; unsigned kt[16], vv[8]; float ebv = 0.f;
    const u16* QB = (const u16*)(p.ws + OFF_GQB);
    const u16* KB2 = (const u16*)((const char*)p.out + OUT_GKB);
    const float* EBE = (const float*)((const char*)p.out + OUT_EBE);
    const u16* qsrc = dir ? QB + h * 128 : P + h * 128;
    const u16* ksrc = dir ? KB2 + h * 128 : P + 512 + h * 128;
    const long rst = dir ? 512 : LDP;
    const long sgn = dir ? -1 : 1;
#define GLA_PREFETCH(ci_) do { const int ci2 = (ci_); const bool isc = ci2 < 4; const int cc = isc ? ci2 : ci2 - 4; const int TT = isc ? CTXL : SEQL; \
      const int base = isc ? ML + b * CTXL : b * SEQL; \
      const int row0 = base + (dir ? TT - 1 - cc * 64 : cc * 64); \
      { const long ro = ((long)row0 + sgn * (tid >> 3)) * rst + (tid & 7) * 8; \
        qx[0] = *(const u32x4*)(qsrc + ro); qx[1] = *(const u32x4*)(qsrc + ro + 64); kx[0] = *(const u32x4*)(ksrc + ro); kx[1] = *(const u32x4*)(ksrc + ro + 64); } \
      { const u16* pk = ksrc + ((long)row0 + sgn * ((tid >> 7) * 8)) * rst + (tid & 127); \
        _Pragma("unroll") for (int i = 0; i < 8; ++i) { kt[i] = pk[sgn * i * rst]; kt[8 + i] = pk[sgn * (32 + i) * rst]; } } \
      { const long sst = dir ? -(long)LDP : (long)LDP; const u16* pv = P + (long)row0 * LDP + (long)(tg * 8) * sst + 1024 + h * 256 + dvs * 64 + dvc; \
        _Pragma("unroll") for (int i = 0; i < 8; ++i) vv[i] = pv[(long)i * sst]; } \
      if (tid < 128) { const int blk = (dir ? row0 - 63 : row0) >> 6; ebv = EBE[(long)(dir * 544 + blk) * 512 + h * 128 + tid]; } } while (0)
    GLA_PREFETCH(0);
    for (int ci = 0; ci < 68; ++ci) {
      asm volatile("" : "+v"(tid));
      const int lane = tid & 63, wid = tid >> 6, l32 = lane & 31, hi = lane >> 5;
      const int tbg = wid >> 2, kd = (wid & 3) * 32 + l32;
      const int dvc = tid & 63, tg = tid >> 6;
      const bool is_ctx = ci < 4; const int c = is_ctx ? ci : ci - 4; const int TT = is_ctx ? CTXL : SEQL;
      const int base = is_ctx ? ML + b * CTXL : b * SEQL;
      char* vT = vT0 + (ci & 1) * 40960;
      {
        if (tid < 128) ebend[tid] = ebv;
        const int r = tid >> 3, c0 = tid & 7;
        *(u32x4*)(qbL + swz256(r, c0)) = qx[0]; *(u32x4*)(qbL + swz256(r, c0 + 8)) = qx[1];
        *(u32x4*)(kinvL + swz256(r, c0)) = kx[0]; *(u32x4*)(kinvL + swz256(r, c0 + 8)) = kx[1];
        const int kdt = tid & 127, tgk = tid >> 7;
        u32x4 w0 = {kt[0] | (kt[1] << 16), kt[2] | (kt[3] << 16), kt[4] | (kt[5] << 16), kt[6] | (kt[7] << 16)};
        u32x4 w1 = {kt[8] | (kt[9] << 16), kt[10] | (kt[11] << 16), kt[12] | (kt[13] << 16), kt[14] | (kt[15] << 16)};
        *(u32x4*)(kendT + swz128(kdt, tgk)) = w0;
        *(u32x4*)(kendT + swz128(kdt, tgk + 4)) = w1;
        u32x4 wv = {vv[0] | (vv[1] << 16), vv[2] | (vv[3] << 16), vv[4] | (vv[5] << 16), vv[6] | (vv[7] << 16)};
        *(u32x4*)(vT + swz128(dvc, tg)) = wv;
      }
      __builtin_amdgcn_sched_barrier(0);
      if (ci + 1 < 68) GLA_PREFETCH(ci + 1);
      __builtin_amdgcn_sched_barrier(0);
      __syncthreads();
      f32x16 oacc;
#pragma unroll
      for (int r = 0; r < 16; ++r) oacc[r] = 0.f;
      const int tbo = (wid - 4) >> 1, dvbo = (wid - 4) & 1;
      if (wid < 4) {
        const int sb = wid & 1, tb = wid >> 1;
        if (sb <= tb) {
          f32x16 sacc;
#pragma unroll
          for (int r = 0; r < 16; ++r) sacc[r] = 0.f;
          bf16x8 av[8], bv8[8];
#pragma unroll
          for (int k16 = 0; k16 < 8; ++k16) {
            av[k16] = *(const bf16x8*)(kinvL + swz256(sb * 32 + l32, k16 * 2 + hi));
            bv8[k16] = *(const bf16x8*)(qbL + swz256(tb * 32 + l32, k16 * 2 + hi));
          }
#pragma unroll
          for (int k16 = 0; k16 < 8; ++k16) sacc = __builtin_amdgcn_mfma_f32_32x32x16_bf16(av[k16], bv8[k16], sacc, 0, 0, 0);
          const int t = tb * 32 + l32;
#pragma unroll
          for (int rg = 0; rg < 4; ++rg) {
            const int s0 = sb * 32 + 8 * rg + 4 * hi;
            const float v0 = (s0 + 0 <= t) ? sacc[rg * 4 + 0] : 0.f, v1 = (s0 + 1 <= t) ? sacc[rg * 4 + 1] : 0.f;
            const float v2 = (s0 + 2 <= t) ? sacc[rg * 4 + 2] : 0.f, v3 = (s0 + 3 <= t) ? sacc[rg * 4 + 3] : 0.f;
            u32x2 w = {cvtpk(v0, v1), cvtpk(v2, v3)};
            *(u32x2*)(scL + swz128(t, s0 >> 3) + (s0 & 7) * 2) = w;
          }
        }
      } else {
        bf16x8 av[8], bv8[8];
#pragma unroll
        for (int k16 = 0; k16 < 8; ++k16) {
          av[k16] = *(const bf16x8*)(qbL + swz256(tbo * 32 + l32, k16 * 2 + hi));
          bv8[k16] = *(const bf16x8*)(STL + swz256(dvbo * 32 + l32, k16 * 2 + hi));
        }
#pragma unroll
        for (int k16 = 0; k16 < 8; ++k16) oacc = __builtin_amdgcn_mfma_f32_32x32x16_bf16(av[k16], bv8[k16], oacc, 0, 0, 0);
      }
      const int kb = wid >> 1, dvb2 = wid & 1;
      {
        bf16x8 av[4], bv4[4];
#pragma unroll
        for (int k16 = 0; k16 < 4; ++k16) {
          av[k16] = *(const bf16x8*)(kendT + swz128(kb * 32 + l32, k16 * 2 + hi));
          bv4[k16] = *(const bf16x8*)(vT + swz128(dvb2 * 32 + l32, k16 * 2 + hi));
        }
#pragma unroll
        for (int k16 = 0; k16 < 4; ++k16) Sacc = __builtin_amdgcn_mfma_f32_32x32x16_bf16(av[k16], bv4[k16], Sacc, 0, 0, 0);
#pragma unroll
        for (int rg = 0; rg < 4; ++rg) {
          const f32x4 e4 = *(const f32x4*)(ebend + kb * 32 + 8 * rg + 4 * hi);
          Sacc[rg * 4 + 0] *= e4[0]; Sacc[rg * 4 + 1] *= e4[1]; Sacc[rg * 4 + 2] *= e4[2]; Sacc[rg * 4 + 3] *= e4[3];
        }
      }
      __syncthreads();
      if (wid >= 4) {
#pragma unroll
        for (int k16 = 0; k16 < 4; ++k16) {
          if (k16 < 2 || tbo == 1) {
            const bf16x8 a = *(const bf16x8*)(scL + swz128(tbo * 32 + l32, k16 * 2 + hi));
            const bf16x8 bv = *(const bf16x8*)(vT + swz128(dvbo * 32 + l32, k16 * 2 + hi));
            oacc = __builtin_amdgcn_mfma_f32_32x32x16_bf16(a, bv, oacc, 0, 0, 0);
          }
        }
        if (!is_ctx || need_ctx) {
          u16* O = dir ? OB : OF;
#pragma unroll
          for (int r = 0; r < 16; ++r) {
            const int pos = c * 64 + tbo * 32 + crow(r, hi);
            const int tok = dir ? TT - 1 - pos : pos;
            O[(size_t)(base + tok) * 1024 + h * 256 + dvs * 64 + dvbo * 32 + l32] = f2bf(oacc[r]);
          }
        }
      }
      {
        const int dv = dvb2 * 32 + l32;
#pragma unroll
        for (int rg = 0; rg < 4; ++rg) {
          const int k0 = kb * 32 + 8 * rg + 4 * hi;
          u32x2 w = {cvtpk(Sacc[rg * 4 + 0], Sacc[rg * 4 + 1]), cvtpk(Sacc[rg * 4 + 2], Sacc[rg * 4 + 3])};
          *(u32x2*)(STL + swz256(dv, k0 >> 3) + (k0 & 7) * 2) = w;
        }
      }
    }
#undef GLA_PREFETCH
    __syncthreads();
  }
}

__device__ __forceinline__ void gla_prep_phase(const Params& p, int j, int Mrows, int tid, int bid) {
  const int lane = tid & 63, wid = tid >> 6;
  const u16* P = (const u16*)(p.ws + OFF_S);
  const u16* OF = (const u16*)((char*)p.out + OUT_H);
  u16* OB = (u16*)(p.ws + OFF_GLA_OB);
  const float4 g = *(const float4*)(p.in[15] + (size_t)j * 256 + lane * 4);
  for (int row = bid * 8 + wid; row < Mrows; row += gridDim.x * 8) {
    u32x2 a[4], bq[4], rr[4];
#pragma unroll
    for (int hh = 0; hh < 4; ++hh) {
      const size_t o = (size_t)row * 1024 + hh * 256 + lane * 4;
      a[hh] = *(const u32x2*)(OF + o); bq[hh] = *(const u32x2*)(OB + o);
      rr[hh] = *(const u32x2*)(P + (size_t)row * LDP + 2048 + hh * 256 + lane * 4);
    }
#pragma unroll
    for (int hh = 0; hh < 4; ++hh) {
      const size_t o = (size_t)row * 1024 + hh * 256 + lane * 4;
      const float o0 = bflo(a[hh][0]) + bflo(bq[hh][0]), o1 = bfhi(a[hh][0]) + bfhi(bq[hh][0]), o2 = bflo(a[hh][1]) + bflo(bq[hh][1]), o3 = bfhi(a[hh][1]) + bfhi(bq[hh][1]);
      const float ss = wave_sum(o0 * o0 + o1 * o1 + o2 * o2 + o3 * o3);
      const float rstd = rsqrtf(ss * (1.f / 256.f) + EPSN);
      const float r0 = bflo(rr[hh][0]), r1 = bfhi(rr[hh][0]), r2 = bflo(rr[hh][1]), r3 = bfhi(rr[hh][1]);
      const float y0 = o0 * rstd * g.x * (r0 * sigmoidf_(r0)), y1 = o1 * rstd * g.y * (r1 * sigmoidf_(r1));
      const float y2 = o2 * rstd * g.z * (r2 * sigmoidf_(r2)), y3 = o3 * rstd * g.w * (r3 * sigmoidf_(r3));
      u32x2 w = {cvtpk(y0, y1), cvtpk(y2, y3)};
      *(u32x2*)(OB + o) = w;
    }
  }
}

constexpr size_t OFF_LRU_SUM = OFF_S + (size_t)MT * 2048 * 2;
constexpr size_t OFF_LRU_CAR = OFF_LRU_SUM + (size_t)544 * 2 * 1024 * 8;
constexpr size_t OFF_LRU_Y = OFF_LRU_CAR + (size_t)544 * 2 * 1024 * 4;
template <int PASS>
__device__ __forceinline__ void lru_tile_phase(const Params& p, int jl, int Mrows, char* smem, int tid, int bid) {
  char* xcL = smem;
  float* aL = (float*)(smem + 16384);
  float* uL = (float*)(smem + 16384 + 65536);
  const u16* P2 = (const u16*)(p.ws + OFF_S);
  u16* H = (u16*)(p.ws + OFF_LRU_Y);
  float2* summ = (float2*)(p.ws + OFF_LRU_SUM);
  const float* carry = (const float*)(p.ws + OFF_LRU_CAR);
  const u16* Wbd = (const u16*)(p.ws + OFF_WMIX) + 3072 * 1024;
  const int ntt = Mrows / 64;
  bf16x8 wb0[8], wb1[8]; float c_ba = 0.f, c_bx = 0.f, c_sp = 0.f; int n_loaded = -1;
  for (int job = bid; job < ntt * 8; job += gridDim.x) {
    asm volatile("" : "+v"(tid));
    const int lane = tid & 63, wid = tid >> 6, l32 = lane & 31, hi = lane >> 5;
    const int tt = job >> 3, n = job & 7;
    const bool lat = tt < 512;
    const int rowbase = lat ? tt * 64 : ML + (tt - 512) * 64;
    const int sloc = lat ? (tt & 63) * 64 : ((tt - 512) & 3) * 64;
    const int TT = lat ? SEQL : CTXL;
    unsigned gv[16]; float carry_in = 0.f;
    if (PASS == 2) {
      const int ch = tid & 127, tg = tid >> 7;
#pragma unroll
      for (int i = 0; i < 16; ++i) gv[i] = P2[(size_t)(rowbase + tg * 16 + i) * 2048 + n * 128 + ch];
      if (tid < 256) carry_in = carry[(size_t)(tt * 2 + (tid >> 7)) * 1024 + n * 128 + (tid & 127)];
    }
    {
      const int ch = tid & 127, tg = tid >> 7, t0 = tg * 16;
      const int col = n * 128 + ch;
      float cw0 = p.in[18][(size_t)(jl * 4 + 0) * 1024 + col], cw1 = p.in[18][(size_t)(jl * 4 + 1) * 1024 + col];
      float cw2 = p.in[18][(size_t)(jl * 4 + 2) * 1024 + col], cw3 = p.in[18][(size_t)(jl * 4 + 3) * 1024 + col];
      const float cb = p.in[19][(size_t)jl * 1024 + col];
      float xb[19]; unsigned xraw[19];
      const u16* xsrc = P2 + (size_t)(rowbase - sloc) * 2048 + 1024 + col;
#pragma unroll
      for (int i = 0; i < 19; ++i) {
        const int s = sloc + t0 + i - 2;
        const int sc = s < 0 ? 0 : (s >= TT ? TT - 1 : s);
        xraw[i] = xsrc[(size_t)sc * 2048];
      }
#pragma unroll
      for (int i = 0; i < 19; ++i) {
        const int s = sloc + t0 + i - 2;
        xb[i] = (s >= 0 && s < TT) ? __uint_as_float(xraw[i] << 16) : 0.f;
      }
#pragma unroll
      for (int i = 0; i < 16; ++i) {
        const float xc = cb + cw0 * xb[i] + cw1 * xb[i + 1] + cw2 * xb[i + 2] + cw3 * xb[i + 3];
        *(u16*)(xcL + swz256(t0 + i, ch >> 3) + (ch & 7) * 2) = f2bf(xc);
      }
    }
    __syncthreads();
    {
      const int cbk = wid & 3, dh = wid >> 2;
      const int chl = cbk * 32 + l32, col = n * 128 + chl;
      if (n != n_loaded) {
        const u16* wbase = Wbd + (size_t)n * 16384 + (size_t)chl * 128 + hi * 8;
#pragma unroll
        for (int k16 = 0; k16 < 8; ++k16) {
          wb0[k16] = *(const bf16x8*)(wbase + (size_t)(dh * 2 + 0) * 131072 + k16 * 16);
          wb1[k16] = *(const bf16x8*)(wbase + (size_t)(dh * 2 + 1) * 131072 + k16 * 16);
        }
        const float* pba = dh ? p.in[26] : p.in[21]; const float* pbx = dh ? p.in[28] : p.in[23]; const float* plam = dh ? p.in[29] : p.in[24];
        c_ba = pba[(size_t)jl * 1024 + col]; c_bx = pbx[(size_t)jl * 1024 + col];
        c_sp = -8.f * flog(1.f + fexp(-plam[(size_t)jl * 1024 + col]));
        n_loaded = n;
      }
#pragma unroll
      for (int tb = 0; tb < 2; ++tb) {
        f32x16 acc0, acc1;
#pragma unroll
        for (int r = 0; r < 16; ++r) { acc0[r] = 0.f; acc1[r] = 0.f; }
        bf16x8 af[8];
#pragma unroll
        for (int k16 = 0; k16 < 8; ++k16) af[k16] = *(const bf16x8*)(xcL + swz256(tb * 32 + l32, k16 * 2 + hi));
#pragma unroll
        for (int k16 = 0; k16 < 8; ++k16) {
          acc0 = __builtin_amdgcn_mfma_f32_32x32x16_bf16(af[k16], wb0[k16], acc0, 0, 0, 0);
          acc1 = __builtin_amdgcn_mfma_f32_32x32x16_bf16(af[k16], wb1[k16], acc1, 0, 0, 0);
        }
#pragma unroll
        for (int r = 0; r < 16; ++r) {
          const int tok = tb * 32 + crow(r, hi);
          const float xc = bf2f(*(const u16*)(xcL + swz256(tok, chl >> 3) + (chl & 7) * 2));
          const float la = c_sp * __builtin_amdgcn_rcpf(1.f + fexp(-(acc0[r] + c_ba)));
          const float ii = __builtin_amdgcn_rcpf(1.f + fexp(-(acc1[r] + c_bx)));
          const float av = fexp(la);
          aL[(dh * 64 + tok) * 128 + chl] = av;
          uL[(dh * 64 + tok) * 128 + chl] = __builtin_amdgcn_sqrtf(fmaxf(1.f - av * av, 0.f)) * (ii * xc);
        }
      }
    }
    __syncthreads();
    if (tid < 256) {
      const int dir = tid >> 7, ch = tid & 127;
      const size_t sidx = (size_t)(tt * 2 + dir) * 1024 + n * 128 + ch;
      float hst = 0.f, ap = 1.f;
      if (PASS == 2) hst = carry_in;
      const float* ap_ = aL + (dir * 64) * 128 + ch;
      float* up_ = uL + (dir * 64) * 128 + ch;
#pragma unroll 1
      for (int i0 = 0; i0 < 64; i0 += 16) {
        float av[16], uv[16];
#pragma unroll
        for (int k = 0; k < 16; ++k) { const int t = dir ? 63 - (i0 + k) : i0 + k; av[k] = ap_[t * 128]; uv[k] = up_[t * 128]; }
#pragma unroll
        for (int k = 0; k < 16; ++k) { hst = fmaf(av[k], hst, uv[k]); if (PASS == 1) ap *= av[k]; else uv[k] = hst; }
        if (PASS == 2) {
#pragma unroll
          for (int k = 0; k < 16; ++k) { const int t = dir ? 63 - (i0 + k) : i0 + k; up_[t * 128] = uv[k]; }
        }
      }
      if (PASS == 1) summ[sidx] = make_float2(ap, hst);
    }
    if (PASS == 2) {
      __syncthreads();
      const int ch = tid & 127, tg = tid >> 7;
      const int col = n * 128 + ch;
      float hsv[16];
#pragma unroll
      for (int i = 0; i < 16; ++i) { const int t = tg * 16 + i; hsv[i] = uL[(0 * 64 + t) * 128 + ch] + uL[(1 * 64 + t) * 128 + ch]; }
#pragma unroll
      for (int i = 0; i < 16; ++i) {
        const int t = tg * 16 + i;
        const float hs = hsv[i];
        const float gt = __uint_as_float(gv[i] << 16);
        const float z2 = 1.5957691216057308f * (gt + 0.044715f * gt * gt * gt);
        const float gl = gt * __builtin_amdgcn_rcpf(1.f + fexp(-z2));
        H[(size_t)(rowbase + t) * 1024 + col] = f2bf(hs * gl);
      }
    }
    __syncthreads();
  }
}

__device__ __forceinline__ void lru_carry_phase(const Params& p, int tid, int bid) {
  const int g = bid * NTHR + tid;
  if (g >= 16384) return;
  const float2* __restrict__ summ = (const float2*)(p.ws + OFF_LRU_SUM);
  float* __restrict__ carry = (float*)(p.ws + OFF_LRU_CAR);
  const int b = g >> 11, dir = (g >> 10) & 1, ch = g & 1023;
  float hst = 0.f;
#pragma unroll 1
  for (int sb = 0; sb < 68; sb += 17) {
    float2 sv[17]; size_t sidx[17];
#pragma unroll
    for (int k = 0; k < 17; ++k) {
      const int st = sb + k;
      int tt;
      if (st < 4) tt = 512 + b * 4 + (dir ? 3 - st : st);
      else tt = b * 64 + (dir ? 63 - (st - 4) : (st - 4));
      sidx[k] = (size_t)(tt * 2 + dir) * 1024 + ch;
      sv[k] = summ[sidx[k]];
    }
#pragma unroll
    for (int k = 0; k < 17; ++k) { carry[sidx[k]] = hst; hst = fmaf(sv[k].x, hst, sv[k].y); }
  }
}

constexpr size_t OFF_KB = OFF_S + (size_t)MT * 1536 * 2;
constexpr size_t OFF_VB = OFF_KB + (size_t)NBATCH * NKEY * 256 * 2;
constexpr size_t OFF_ATT_O = OFF_VB + (size_t)NBATCH * NKEY * 256 * 2;
__device__ __forceinline__ void qknorm_phase(const Params& p, int ja, int tid, int bid) {
  const int lane = tid & 63, wid = tid >> 6;
  u16* QKV = (u16*)(p.ws + OFF_S);
  u16* KB = (u16*)(p.ws + OFF_KB);
  u16* VB = (u16*)(p.ws + OFF_VB);
  const float qg1 = p.in[32][(size_t)ja * 128 + lane], qg2 = p.in[32][(size_t)ja * 128 + 64 + lane];
  const float kg1 = p.in[33][(size_t)ja * 128 + lane], kg2 = p.in[33][(size_t)ja * 128 + 64 + lane];
  const float invf = exp2f(-(float)(lane & 31) * (13.287712379549449f / 32.f));
  for (int row = bid * 8 + wid; row < MT; row += gridDim.x * 8) {
    const bool lat = row < ML;
    const int t = lat ? (row & 4095) : ((row - ML) & 255);
    const int b = lat ? (row >> 12) : ((row - ML) >> 8);
    const int key = lat ? CTXL + t : t;
    float cs = 1.f, sn = 0.f;
    if (lat) { const float pos = (float)(lane < 32 ? (t >> 6) : (t & 63)); sincosf(pos * invf, &sn, &cs); }
    u16* qr = QKV + (size_t)row * 1536;
    u16* kdst = KB + ((size_t)b * NKEY + key) * 256;
    unsigned xr1[10], xr2[10];
#pragma unroll
    for (int hs = 0; hs < 10; ++hs) { xr1[hs] = qr[hs * 128 + lane]; xr2[hs] = qr[hs * 128 + 64 + lane]; }
    const u32x2 vraw = *(const u32x2*)(qr + 1280 + lane * 4);
#pragma unroll
    for (int hs = 0; hs < 10; ++hs) {
      const float x1 = __uint_as_float(xr1[hs] << 16), x2 = __uint_as_float(xr2[hs] << 16);
      const float ss = wave_sum(x1 * x1 + x2 * x2);
      const float rstd = rsqrtf(ss * (1.f / 128.f) + EPSN);
      const float y1 = x1 * rstd * (hs < 8 ? qg1 : kg1), y2 = x2 * rstd * (hs < 8 ? qg2 : kg2);
      const float o1 = y1 * cs - y2 * sn, o2 = y1 * sn + y2 * cs;
      if (hs < 8) { qr[hs * 128 + lane] = f2bf(o1); qr[hs * 128 + 64 + lane] = f2bf(o2); }
      else { kdst[(hs - 8) * 128 + lane] = f2bf(o1); kdst[(hs - 8) * 128 + 64 + lane] = f2bf(o2); }
    }
    *(u32x2*)(VB + ((size_t)b * NKEY + key) * 256 + lane * 4) = vraw;
  }
}

constexpr int AT_LDQ = 1536, AT_LDK = 256, AT_LDO = 1024;
constexpr float AT_SCALE = 0.088388347648318440f;
constexpr float AT_THR = 8.f;
constexpr size_t SHM_V = 64 * 128 * 2, SHM_K = 64 * 128 * 2;
#define KSWZ(row, colB) ((row) * 256 + ((colB) ^ (((row) & 7) << 4)))
#define SBAR() __builtin_amdgcn_sched_barrier(0)
__device__ __forceinline__ unsigned cvtpkv(float lo, float hi) {
  unsigned r; asm volatile("v_cvt_pk_bf16_f32 %0, %1, %2" : "=v"(r) : "v"(lo), "v"(hi)); return r;
}
__device__ __forceinline__ void partialSM(f32x16& p0, f32x16& p1, float& m_reg, float& mn, float& alpha) {
  constexpr float C = AT_SCALE * 1.4426950408889634f;
  float pmax = p0[0];
#pragma unroll
  for (int r = 1; r < 16; ++r) pmax = fmaxf(pmax, p0[r]);
#pragma unroll
  for (int r = 0; r < 16; ++r) pmax = fmaxf(pmax, p1[r]);
  { auto rr = __builtin_amdgcn_permlane32_swap(__float_as_uint(pmax), __float_as_uint(pmax), false, false);
    pmax = fmaxf(__uint_as_float(rr[0]), __uint_as_float(rr[1])); }
  if (__builtin_expect(__all(pmax - m_reg <= AT_THR / AT_SCALE), 1)) { mn = m_reg; alpha = 1.f; }
  else { mn = fmaxf(m_reg, pmax); alpha = __builtin_amdgcn_exp2f((m_reg - mn) * C); m_reg = mn; }
  float mnC = -mn * C;
#pragma unroll
  for (int r = 0; r < 16; ++r) p0[r] = fmaf(p0[r], C, mnC);
#pragma unroll
  for (int r = 0; r < 16; ++r) p1[r] = fmaf(p1[r], C, mnC);
#pragma unroll
  for (int r = 0; r < 16; ++r) p0[r] = __builtin_amdgcn_exp2f(p0[r]);
}
__device__ __forceinline__ void finishSM(f32x16& p0, f32x16& p1, float alpha, float& l_reg, bf16x8& pa0, bf16x8& pa1, bf16x8& pa2, bf16x8& pa3) {
#pragma unroll
  for (int r = 0; r < 16; ++r) p1[r] = __builtin_amdgcn_exp2f(p1[r]);
  float ps = 0;
#pragma unroll
  for (int r = 0; r < 16; ++r) ps += p0[r];
#pragma unroll
  for (int r = 0; r < 16; ++r) ps += p1[r];
  { auto rr = __builtin_amdgcn_permlane32_swap(__float_as_uint(ps), __float_as_uint(ps), false, false);
    ps = __uint_as_float(rr[0]) + __uint_as_float(rr[1]); }
  l_reg = l_reg * alpha + ps;
#define PK4(P, BASE, OUT) do { unsigned a0 = cvtpkv(P[BASE + 0], P[BASE + 1]), a1 = cvtpkv(P[BASE + 2], P[BASE + 3]);   \
    unsigned b0 = cvtpkv(P[BASE + 4], P[BASE + 5]), b1 = cvtpkv(P[BASE + 6], P[BASE + 7]);                              \
    auto r0 = __builtin_amdgcn_permlane32_swap(a0, b0, false, false); auto r1 = __builtin_amdgcn_permlane32_swap(a1, b1, false, false); \
    u32x4 w = {r0[0], r1[0], r0[1], r1[1]}; OUT = *reinterpret_cast<bf16x8*>(&w); } while (0)
  PK4(p0, 0, pa0); PK4(p0, 8, pa1); PK4(p1, 0, pa2); PK4(p1, 8, pa3);
#undef PK4
}
__device__ __forceinline__ void qkt(f32x16& p0, f32x16& p1, const char* Ks, const bf16x8* qr, int r32, int hi) {
#pragma unroll
  for (int r = 0; r < 16; ++r) { p0[r] = 0.f; p1[r] = 0.f; }
#pragma unroll
  for (int d0 = 0; d0 < 8; ++d0) { int cb = (d0 * 16 + hi * 8) * 2;
    bf16x8 b0 = *reinterpret_cast<const bf16x8*>(Ks + KSWZ(r32, cb));
    bf16x8 b1 = *reinterpret_cast<const bf16x8*>(Ks + KSWZ(32 + r32, cb));
    p0 = __builtin_amdgcn_mfma_f32_32x32x16_bf16(b0, qr[d0], p0, 0, 0, 0);
    p1 = __builtin_amdgcn_mfma_f32_32x32x16_bf16(b1, qr[d0], p1, 0, 0, 0); }
}
__device__ __forceinline__ int v_st(int k, int c) { const int kk = (k & ~0xC) | ((k & 4) << 1) | ((k & 8) >> 1); return ((kk >> 3) * 4 + (c >> 5)) * 512 + ((kk & 7) * 32 + (c & 31)) * 2; }
__device__ __forceinline__ int v_rd_base(int lane) { return ((lane & 3) << 3) | (((lane >> 2) & 3) << 6) | (((lane >> 4) & 1) << 5) | (((lane >> 5) & 1) << 8); }
constexpr int v_rd_off(int d0, int ks, int half) { return d0 * 512 + ks * 4096 + half * 2048; }
template <int OFF> __device__ __forceinline__ s16x4 tr_read(int vb) {
  s16x4 r; asm volatile("ds_read_b64_tr_b16 %0, %1 offset:%2" : "=&v"(r) : "v"(vb), "i"(OFF) : "memory"); return r;
}
template <int D0> __device__ __forceinline__ void pv_one(f32x16& od, int vb, bf16x8 pa0, bf16x8 pa1, bf16x8 pa2, bf16x8 pa3) {
  const s16x4 l0 = tr_read<v_rd_off(D0, 0, 0)>(vb), h0 = tr_read<v_rd_off(D0, 0, 1)>(vb), l1 = tr_read<v_rd_off(D0, 1, 0)>(vb), h1 = tr_read<v_rd_off(D0, 1, 1)>(vb);
  const s16x4 l2 = tr_read<v_rd_off(D0, 2, 0)>(vb), h2 = tr_read<v_rd_off(D0, 2, 1)>(vb), l3 = tr_read<v_rd_off(D0, 3, 0)>(vb), h3 = tr_read<v_rd_off(D0, 3, 1)>(vb);
  asm volatile("s_waitcnt lgkmcnt(0)" ::: "memory"); SBAR();
#define PK(L, H) (bf16x8){L[0], L[1], L[2], L[3], H[0], H[1], H[2], H[3]}
  od = __builtin_amdgcn_mfma_f32_32x32x16_bf16(pa0, PK(l0, h0), od, 0, 0, 0);
  od = __builtin_amdgcn_mfma_f32_32x32x16_bf16(pa1, PK(l1, h1), od, 0, 0, 0);
  od = __builtin_amdgcn_mfma_f32_32x32x16_bf16(pa2, PK(l2, h2), od, 0, 0, 0);
  od = __builtin_amdgcn_mfma_f32_32x32x16_bf16(pa3, PK(l3, h3), od, 0, 0, 0);
#undef PK
}
__device__ __forceinline__ void pv_d0(f32x16* o, int vb, bf16x8 pa0, bf16x8 pa1, bf16x8 pa2, bf16x8 pa3) {
  pv_one<0>(o[0], vb, pa0, pa1, pa2, pa3); pv_one<1>(o[1], vb, pa0, pa1, pa2, pa3); pv_one<2>(o[2], vb, pa0, pa1, pa2, pa3); pv_one<3>(o[3], vb, pa0, pa1, pa2, pa3);
}
__device__ __forceinline__ void attn_dense_body(const u16* __restrict__ Qb, const u16* __restrict__ Kh, const u16* __restrict__ Vh,
                                                u16* __restrict__ Ob, int seq, char* lds, int tid) {
  const int wid = tid >> 6, lane = tid & 63, r32 = lane & 31, hi = lane >> 5;
  char* V_lds = lds; char* K_lds = lds + 2 * SHM_V;
  float* wsl = (float*)(lds + 2 * SHM_V + 2 * SHM_K) + wid * 64; float* li_l = wsl; float* al_l = wsl + 32;
  float m_reg = -1e30f, l_reg = 0; f32x16 o[4]; bf16x8 qr[8];
#pragma unroll
  for (int d = 0; d < 4; ++d)
#pragma unroll
    for (int r = 0; r < 16; ++r) o[d][r] = 0.f;
  const u16* Qw = Qb + (long)(wid * 32 + r32) * AT_LDQ + hi * 8;
#pragma unroll
  for (int d0 = 0; d0 < 8; ++d0) qr[d0] = *reinterpret_cast<const bf16x8*>(Qw + d0 * 16);
  const int sr = tid >> 4, sc = (tid & 15) * 8, vst0 = v_st(sr, sc), vst1 = v_st(32 + sr, sc);
  const int vb0 = (int)(uintptr_t)V_lds + v_rd_base(lane);
  struct { bf16x8 vs0, vs1, ks0, ks1; } sr_[2];
#define SLOAD(i, k0) do { sr_[i].vs0 = *(const bf16x8*)(&Vh[(long)((k0) + sr) * AT_LDK + sc]); sr_[i].vs1 = *(const bf16x8*)(&Vh[(long)((k0) + 32 + sr) * AT_LDK + sc]); \
    sr_[i].ks0 = *(const bf16x8*)(&Kh[(long)((k0) + sr) * AT_LDK + sc]); sr_[i].ks1 = *(const bf16x8*)(&Kh[(long)((k0) + 32 + sr) * AT_LDK + sc]); } while (0)
#define SWRITE(b, i) do { *(bf16x8*)(V_lds + (b) * SHM_V + vst0) = sr_[i].vs0;          \
    *(bf16x8*)(V_lds + (b) * SHM_V + vst1) = sr_[i].vs1; int kc = sc * 2;               \
    *(bf16x8*)(K_lds + (b) * SHM_K + KSWZ(sr, kc)) = sr_[i].ks0;                       \
    *(bf16x8*)(K_lds + (b) * SHM_K + KSWZ(32 + sr, kc)) = sr_[i].ks1; } while (0)
#define SWAIT() asm volatile("s_waitcnt vmcnt(4)" ::: "memory")
#define RESC(a) do { if (__any((a) < 1.f)) { if (hi == 0) al_l[r32] = (a); asm volatile("s_waitcnt lgkmcnt(0)" ::: "memory"); \
    for (int d = 0; d < 4; ++d) for (int r = 0; r < 16; ++r) o[d][r] *= al_l[crow(r, hi)]; } } while (0)
  f32x16 pA0, pA1, pB0, pB1; float mnA, mnB, alA, alB; bf16x8 pa0, pa1, pa2, pa3; const int NT = seq / 64;
  constexpr int SE = 0, SO = 1;
  SLOAD(SE, 0); asm volatile("s_waitcnt vmcnt(0)" ::: "memory"); SWRITE(0, SE); __syncthreads();
  qkt(pA0, pA1, K_lds, qr, r32, hi); partialSM(pA0, pA1, m_reg, mnA, alA);
  SLOAD(SO, 64); if (2 < NT) SLOAD(SE, 2 * 64);
  SWAIT(); SWRITE(1, SO); __syncthreads();
  for (int j = 1; j + 1 < NT; j += 2) {
    SBAR(); qkt(pB0, pB1, K_lds + SHM_K, qr, r32, hi);
    finishSM(pA0, pA1, alA, l_reg, pa0, pa1, pa2, pa3); SBAR();
    SLOAD(SO, (j + 2) * 64); SBAR();
    pv_d0(o, vb0, pa0, pa1, pa2, pa3); partialSM(pB0, pB1, m_reg, mnB, alB);
    __syncthreads(); SWAIT(); SWRITE(0, SE);
    RESC(alB); __syncthreads();
    SBAR(); qkt(pA0, pA1, K_lds, qr, r32, hi);
    finishSM(pB0, pB1, alB, l_reg, pa0, pa1, pa2, pa3); SBAR();
    if (j + 3 < NT) SLOAD(SE, (j + 3) * 64); SBAR();
    pv_d0(o, vb0 + (int)SHM_V, pa0, pa1, pa2, pa3); partialSM(pA0, pA1, m_reg, mnA, alA);
    __syncthreads(); SWAIT(); SWRITE(1, SO);
    RESC(alA); __syncthreads();
  }
  SBAR(); qkt(pB0, pB1, K_lds + SHM_K, qr, r32, hi);
  finishSM(pA0, pA1, alA, l_reg, pa0, pa1, pa2, pa3); SBAR();
  pv_d0(o, vb0, pa0, pa1, pa2, pa3); partialSM(pB0, pB1, m_reg, mnB, alB);
  __syncthreads(); RESC(alB);
  finishSM(pB0, pB1, alB, l_reg, pa0, pa1, pa2, pa3); SBAR();
  pv_d0(o, vb0 + (int)SHM_V, pa0, pa1, pa2, pa3);
  if (hi == 0) li_l[r32] = l_reg; asm volatile("s_waitcnt lgkmcnt(0)" ::: "memory");
  float rli[16];
#pragma unroll
  for (int r = 0; r < 16; ++r) rli[r] = __builtin_amdgcn_rcpf(li_l[crow(r, hi)]);
  u16* Ow = Ob + (long)(wid * 32) * AT_LDO;
#pragma unroll
  for (int r = 0; r < 16; ++r) { int orow = crow(r, hi);
#pragma unroll
    for (int d0 = 0; d0 < 4; ++d0) Ow[(long)orow * AT_LDO + d0 * 32 + r32] = f2bf(o[d0][r] * rli[r]); }
#undef SLOAD
#undef SWRITE
#undef SWAIT
#undef RESC
}

__device__ __forceinline__ void attn_phase(const Params& p, bool need_ctx, char* smem, int tid, int bid) {
  const u16* QKV = (const u16*)(p.ws + OFF_S);
  const u16* KB = (const u16*)(p.ws + OFF_KB);
  const u16* VB = (const u16*)(p.ws + OFF_VB);
  u16* H = (u16*)(p.ws + OFF_ATT_O);
  const int NU = need_ctx ? 1088 : 1024;
  for (int it = bid; it < NU; it += gridDim.x) {
    asm volatile("" : "+v"(tid));
    const int v = it < 1024 ? (it & 7) * 128 + (it >> 3) : it;
    int b, h, row0, seq;
    if (v < 1024) { b = v >> 7; const int kvh = (v >> 6) & 1, rest = v & 63; h = kvh * 4 + (rest & 3); row0 = b * SEQL + (rest >> 2) * 256; seq = NKEY; }
    else { const int c = v - 1024; b = c >> 3; h = c & 7; row0 = ML + b * CTXL; seq = CTXL; }
    const int kvh = h >> 2;
    attn_dense_body(QKV + (size_t)row0 * 1536 + h * 128, KB + (size_t)b * NKEY * 256 + kvh * 128, VB + (size_t)b * NKEY * 256 + kvh * 128,
                    H + (size_t)row0 * 1024 + h * 128, seq, smem, tid);
    __syncthreads();
  }
}

enum { OP_MOD = 0, OP_N1, OP_IN, OP_GSCAN, OP_GPREP, OP_OUT, OP_N2, OP_UP, OP_DOWN, OP_LP1, OP_LCAR, OP_LP2, OP_QKN, OP_ATT, OP_FINAL, OP_CFIX1, OP_CFIX2, OP_GPRE };
constexpr int NPHASE = 36;
constexpr int PROBE_OP = -1, PROBE_REP = 1, PROBE_XBAR = 0;
__device__ __forceinline__ void decode_phase(int ph, int& layer, int& op) {
  if (ph == 0) { layer = 0; op = OP_MOD; return; }
  if (ph == NPHASE - 1) { layer = 3; op = OP_FINAL; return; }
  int q = ph - 1;
  if (q < 10) { layer = 0; op = q == 0 ? OP_N1 : q == 1 ? OP_IN : q == 2 ? OP_GPRE : q == 3 ? OP_GSCAN : q == 4 ? OP_GPREP : q == 5 ? OP_OUT : q == 6 ? OP_CFIX1 : q == 7 ? OP_UP : q == 8 ? OP_DOWN : OP_CFIX2; }
  else if (q < 19) { layer = 1; q -= 10; op = q == 0 ? OP_IN : q == 1 ? OP_LP1 : q == 2 ? OP_LCAR : q == 3 ? OP_LP2 : q == 4 ? OP_OUT : q == 5 ? OP_CFIX1 : q == 6 ? OP_UP : q == 7 ? OP_DOWN : OP_CFIX2; }
  else if (q < 27) { layer = 2; q -= 19; op = q == 0 ? OP_IN : q == 1 ? OP_QKN : q == 2 ? OP_ATT : q == 3 ? OP_OUT : q == 4 ? OP_CFIX1 : q == 5 ? OP_UP : q == 6 ? OP_DOWN : OP_CFIX2; }
  else { layer = 3; q -= 27; op = q == 0 ? OP_IN : q == 1 ? OP_GPRE : q == 2 ? OP_GSCAN : q == 3 ? OP_GPREP : q == 4 ? OP_OUT : q == 5 ? OP_UP : OP_DOWN; }
}

#define XB_XCNT(j)  (256  + 64 * (j))
#define XB_XSUB(j)  (1280 + 64 * (j))
#define XB_XGEN(j)  (2304 + 64 * (j))
#define XB_TOP      3328
#define XB_TOPGEN   3392
#define XB_WORDS    3456
__device__ __forceinline__ unsigned xb_ld(unsigned* p) { return __hip_atomic_load(p, __ATOMIC_RELAXED, __HIP_MEMORY_SCOPE_AGENT); }
__device__ __forceinline__ unsigned xb_add(unsigned* p, unsigned v) { return __hip_atomic_fetch_add(p, v, __ATOMIC_RELAXED, __HIP_MEMORY_SCOPE_AGENT); }
__device__ __forceinline__ unsigned xb_xcc_id() { return (unsigned)__builtin_amdgcn_s_getreg((3 << 11) | 20) & 0xFu; }
__device__ __forceinline__ void grid_barrier(unsigned* bar, volatile unsigned* st) {
  asm volatile("s_waitcnt vmcnt(0)" ::: "memory");
  __syncthreads();
  if (threadIdx.x == 0) {
    __builtin_amdgcn_s_waitcnt(0);
    const unsigned x = st[2], nloc = st[0], nx = st[1];
    const unsigned old = xb_add(&bar[XB_XSUB(x)], 1u);
    const unsigned gen = old / nloc;
    if (old + 1u == (gen + 1u) * nloc) {
      __builtin_amdgcn_fence(__ATOMIC_RELEASE, "agent");
      asm volatile("s_waitcnt vmcnt(0)" ::: "memory");
      const unsigned og = xb_add(&bar[XB_TOP], 1u);
      const unsigned tg = og / nx;
      if (og + 1u == (tg + 1u) * nx) xb_add(&bar[XB_TOPGEN], 1u);
      else { while (xb_ld(&bar[XB_TOPGEN]) == tg) __builtin_amdgcn_s_sleep(1); }
      __builtin_amdgcn_fence(__ATOMIC_ACQUIRE, "agent");
      xb_add(&bar[XB_XGEN(x)], 1u);
      asm volatile("s_waitcnt vmcnt(0)" ::: "memory");
    } else {
      while (xb_ld(&bar[XB_XGEN(x)]) == gen) __builtin_amdgcn_s_sleep(1);
      __builtin_amdgcn_fence(__ATOMIC_ACQUIRE, "agent");
      asm volatile("s_waitcnt vmcnt(0)" ::: "memory");
    }
  }
  __syncthreads();
}

__global__ void __launch_bounds__(NTHR) fwd_megakernel(Params p, int ph_lo, int ph_hi) {
  extern __shared__ __attribute__((aligned(16))) char smem[];
  cg::grid_group grid = cg::this_grid();
  u16* H = (u16*)((char*)p.out + OUT_H);
  u16* S = (u16*)(p.ws + OFF_S);
  u16* WM = (u16*)(p.ws + OFF_WMIX);
  u16* WP = (u16*)(p.ws + OFF_WMLP);
  const float* mod = (const float*)(p.ws + OFF_MOD);
  unsigned nbar = 0; bool replayed = false;
  unsigned* bar = (unsigned*)(p.ws + OFF_BAR);
  volatile unsigned* xst = (volatile unsigned*)(smem + SMEM_BYTES);
  bool census_done = false;
  if (threadIdx.x == 0) { const unsigned x = xb_xcc_id(); xst[2] = x; xb_add(&bar[XB_XCNT(x)], 1u); }
  for (int ph = ph_lo; ph < ph_hi; ++ph) {
    int layer, op;
    decode_phase(ph, layer, op);
    int tid = threadIdx.x; asm volatile("" : "+v"(tid));
    int bid = blockIdx.x; asm volatile("" : "+s"(bid));
    const int kind = layer % 3, jj = layer / 3;
    const bool need_ctx = layer < 3;
    const int Mout = need_ctx ? MT : ML;
    switch (op) {
      case OP_MOD: mod_phase(p, smem, tid, bid); break;
      case OP_N1: norm_phase(p, layer, 0, MT, tid, bid); __syncthreads(); cvt_layer(p, 0, smem, tid, bid, (int)gridDim.x, true, true); __syncthreads(); bias_phase(p, smem, tid, bid); break;
      case OP_IN:
        { const int Nn = kind == 0 ? 3328 : kind == 1 ? 2048 : 1536, ldo = kind == 0 ? LDP : Nn;
          const float* bi = (const float*)((char*)p.out + OUT_BIAS) + (size_t)((layer * 2 + 0) * 9) * 4096;
          gemm8_phase(smem, H, WM, MT, Nn, 1024, EpiStoreP{S, ldo, ldo, 0, layer == 0 ? (const float*)nullptr : (const float*)((char*)p.out + OUT_SSQ), bi}, tid, bid);
          if (layer > 0) { __syncthreads();
            const int skip = (gridDim.x == 256) ? (kind == 1 ? 64 : kind == 2 ? 48 : 0) : 0;
            cvt_layer(p, layer, smem, tid, bid < skip ? -1 : bid - skip, (int)gridDim.x - skip, false, true); } }
        break;
      case OP_GPRE: gla_pre_phase(p, jj, smem, tid, bid); break;
      case OP_GSCAN: gla_scan_phase(p, jj, need_ctx, smem, tid, bid); break;
      case OP_GPREP: gla_prep_phase(p, jj, Mout, tid, bid); break;
      case OP_OUT: {
        const u16* wo = WM + (kind == 0 ? 3328 * 1024 : kind == 1 ? 2048 * 1024 : 1536 * 1024);
        const u16* Ya = (const u16*)(p.ws + (kind == 0 ? OFF_GLA_OB : kind == 1 ? OFF_LRU_Y : OFF_ATT_O));
        const float* gm = (const float*)((char*)p.out + OUT_GAM) + (size_t)((layer * 2 + 1) * 9) * 1024;
        gemm8_phase(smem, Ya, wo, ML, 1024, 1024, EpiResidP{&p, layer == 0, mod + (size_t)layer * 9 * 6144 + 2048, true, gm, H, (float*)((char*)p.out + OUT_SSQ)}, tid, bid);
        if (layer < 3) gemm8_phase(smem, Ya + (size_t)ML * 1024, wo, MC, 1024, 512, EpiPart{(float*)(p.ws + OFF_PART)}, tid, bid, 1024, 2);
      } break;
      case OP_CFIX1: ctx_fix_phase(p, layer == 0, mod + (size_t)(layer * 9 + 8) * 6144 + 2048, (const float*)((char*)p.out + OUT_GAM) + (size_t)((layer * 2 + 1) * 9 + 8) * 1024, 2, tid, bid); break;
      case OP_CFIX2: ctx_fix_phase(p, false, mod + (size_t)(layer * 9 + 8) * 6144 + 5120, (const float*)((char*)p.out + OUT_GAM) + (size_t)(((layer + 1) * 2 + 0) * 9 + 8) * 1024, 4, tid, bid); break;
      case OP_UP: {
        const float* bi = (const float*)((char*)p.out + OUT_BIAS) + (size_t)((layer * 2 + 1) * 9) * 4096;
        gemm8_phase(smem, H, WP, Mout, 4096, 1024, EpiStoreP{S, 4096, 4096, 1, (const float*)((char*)p.out + OUT_SSQ), bi}, tid, bid);
        if (layer < 3) { __syncthreads();
          const int skip = (gridDim.x == 256) ? 128 : 0;
          cvt_layer(p, layer + 1, smem, tid, bid < skip ? -1 : bid - skip, (int)gridDim.x - skip, true, false); }
      } break;
      case OP_DOWN: {
        const int ln = layer < 3 ? layer + 1 : 3;
        const float* gm = (const float*)((char*)p.out + OUT_GAM) + (size_t)((ln * 2 + 0) * 9) * 1024;
        gemm8_phase(smem, S, WP + 4096 * 1024, ML, 1024, 4096, EpiResidP{&p, false, mod + (size_t)layer * 9 * 6144 + 5120, layer < 3, gm, H, (float*)((char*)p.out + OUT_SSQ)}, tid, bid);
        if (layer < 3) {
          gemm8_phase(smem, S + (size_t)ML * 4096, WP + 4096 * 1024, MC, 1024, 1024, EpiPart{(float*)(p.ws + OFF_PART)}, tid, bid, 4096, 4);
        }
      } break;
      case OP_LP1: lru_tile_phase<1>(p, jj, MT, smem, tid, bid); break;
      case OP_LCAR: lru_carry_phase(p, tid, bid); break;
      case OP_LP2: lru_tile_phase<2>(p, jj, Mout, smem, tid, bid); break;
      case OP_QKN: qknorm_phase(p, jj, tid, bid); break;
      case OP_ATT: attn_phase(p, need_ctx, smem, tid, bid); break;
      case OP_FINAL: final_norm_phase(p, tid, bid); break;
    }
    if (ph + 1 < ph_hi) {
      if (!census_done) {
        grid.sync();
        if (threadIdx.x == 0) {
          const unsigned x = xst[2]; unsigned cnt = 0u, mine = 1u;
          for (unsigned jx = 0; jx < 16; ++jx) { const unsigned c = xb_ld(&bar[XB_XCNT(jx)]); cnt += (c > 0u) ? 1u : 0u; if (jx == x) mine = c; }
          xst[0] = mine; xst[1] = cnt;
        }
        __syncthreads();
        census_done = true;
      } else {
        for (int xb = 0; xb < PROBE_XBAR; ++xb) grid_barrier(bar, xst);
        grid_barrier(bar, xst);
      }
    }
    if (PROBE_REP > 1 && op == PROBE_OP && !replayed) { replayed = true; --ph; } else replayed = false;
  }
}

extern "C" void kernel_launch(void* const* d_in, const int* in_sizes, int n_in, void* d_out, int out_size, void* d_ws, size_t ws_size,
                              hipStream_t stream) {
  static int grid_blocks = 0;
  if (!grid_blocks) {
    int dev = 0, cus = 0, per_cu = 0;
    (void)hipGetDevice(&dev);
    (void)hipDeviceGetAttribute(&cus, hipDeviceAttributeMultiprocessorCount, dev);
    (void)hipFuncSetAttribute((const void*)fwd_megakernel, hipFuncAttributeMaxDynamicSharedMemorySize, SMEM_BYTES + 16);
    (void)hipOccupancyMaxActiveBlocksPerMultiprocessor(&per_cu, fwd_megakernel, NTHR, SMEM_BYTES + 16);
    if (per_cu < 1) per_cu = 1;
    if (per_cu > 1) per_cu = 1;
    grid_blocks = cus * per_cu;
    if (ws_size < WS_NEED || (size_t)out_size * 4 < OUT_END2) fprintf(stderr, "workspace too small: %zu < %zu\n", ws_size, (size_t)WS_NEED);
  }
  if (n_in < 36) return;
  Params p{};
  for (int i = 0; i < 36; ++i) p.in[i] = (const float*)d_in[i];
  p.out = (float*)d_out;
  p.ws = (char*)d_ws;
  (void)hipMemsetAsync((char*)d_ws + OFF_BAR, 0, 16384, stream);
  int lo = 0, hi = NPHASE;
  void* args[] = {&p, &lo, &hi};
  hipError_t e = hipLaunchCooperativeKernel((void*)fwd_megakernel, dim3(grid_blocks), dim3(NTHR), args, SMEM_BYTES + 16, stream);
  if (e != hipSuccess) fprintf(stderr, "cooperative launch failed: %s (grid %d)\n", hipGetErrorString(e), grid_blocks);
}
```
